# Optimizing an MI355X kernel written in HIP

```python
import jax, jax.numpy as jnp
from jax import lax
import numpy as np

D_MODEL = 1024
BATCH = 4
SEQ = 8192
DEPTH = 2
DEC_BATCH = 32
DEC_SEQ = 64
PAST_LEN = 1024

CHUNK = 64
Q_BLOCK = 128
EPS = 1e-6
N_MIXERS = 2
N_GLA_LAYERS = (DEPTH + 1) // 2
N_MLA_LAYERS = DEPTH // 2

D_FF = 2816

GLA_HEADS = 4
GLA_DK = D_MODEL // 2 // GLA_HEADS
GLA_DV = D_MODEL // GLA_HEADS
GLA_GATE_RANK = 16
GLA_GATE_NORM = 16.0
GLA_QK = GLA_HEADS * GLA_DK
GLA_VW = GLA_HEADS * GLA_DV
GLA_IN = 2 * GLA_QK + 2 * GLA_VW + GLA_GATE_RANK

MLA_HEADS = 8
MLA_NOPE = 128
MLA_ROPE = 64
MLA_V = 128
MLA_Q_LORA = 384
MLA_KV_LORA = 256
MLA_DOWN = MLA_Q_LORA + MLA_KV_LORA + MLA_ROPE
MLA_SCALE = (MLA_NOPE + MLA_ROPE) ** -0.5
ROPE_THETA = 10000.0

kernel_name = 'hybrid_gla_mla_macaron_stream_step'


def rmsnorm(x, g):
    xf = x.astype(jnp.float32)
    y = xf * lax.rsqrt(jnp.mean(xf * xf, axis=-1, keepdims=True) + EPS)
    return (y * g.astype(jnp.float32)).astype(x.dtype)


def swiglu(x, w_gate, w_up, w_down):
    return (jax.nn.silu(x @ w_gate) * (x @ w_up)) @ w_down


def rope(x, pos):
    half = MLA_ROPE // 2
    inv = ROPE_THETA ** (-jnp.arange(half, dtype=jnp.float32) / half)
    ang = pos.astype(jnp.float32)[:, None] * inv[None, :]
    ang = ang.reshape((ang.shape[0],) + (1,) * (x.ndim - 3) + (half,))
    cos, sin = jnp.cos(ang), jnp.sin(ang)
    x1, x2 = jnp.split(x.astype(jnp.float32), 2, axis=-1)
    return jnp.concatenate([x1 * cos - x2 * sin, x1 * sin + x2 * cos], axis=-1).astype(x.dtype)


def gla_recurrence(q, k, v, log_a, s0):
    B, L, H, _ = q.shape
    C = min(CHUNK, L)
    nc = L // C

    def to_chunks(t):
        return t.astype(jnp.float32).reshape(B, nc, C, H, t.shape[-1]).transpose(1, 0, 3, 2, 4)

    qc, kc, vc, ac = to_chunks(q), to_chunks(k), to_chunks(v), to_chunks(log_a)
    causal = jnp.tril(jnp.ones((C, C), dtype=bool))

    def step(s, inp):
        qi, ki, vi, ai = inp
        b = jnp.cumsum(ai, axis=-2)
        q_dec = qi * jnp.exp(b)
        k_inv = ki * jnp.exp(-b)
        scores = jnp.where(causal, jnp.einsum('bhtk,bhsk->bhts', q_dec, k_inv), 0.0)
        o = jnp.einsum('bhts,bhsv->bhtv', scores, vi) + jnp.einsum('bhtk,bhkv->bhtv', q_dec, s)
        b_last = b[:, :, -1:, :]
        k_tail = ki * jnp.exp(b_last - b)
        s_new = s * jnp.exp(b_last[:, :, 0, :, None]) + jnp.einsum('bhsk,bhsv->bhkv', k_tail, vi)
        return s_new, o

    s_fin, o = lax.scan(step, s0.astype(jnp.float32), (qc, kc, vc, ac))
    o = o.transpose(1, 0, 3, 2, 4).reshape(B, L, H, -1)
    return o, s_fin


def gla_mixer(h, s0, w_in, w_gk_up, b_gk, g_norm, w_out):
    B, L, _ = h.shape
    proj = h @ w_in
    q, k, v, g, gk_low = jnp.split(proj, [GLA_QK, 2 * GLA_QK, 2 * GLA_QK + GLA_VW, 2 * GLA_QK + 2 * GLA_VW], axis=-1)
    log_a = jax.nn.log_sigmoid((gk_low @ w_gk_up + b_gk).astype(jnp.float32)) / GLA_GATE_NORM
    q = q.reshape(B, L, GLA_HEADS, GLA_DK) * (GLA_DK ** -0.5)
    k = k.reshape(B, L, GLA_HEADS, GLA_DK)
    v = v.reshape(B, L, GLA_HEADS, GLA_DV)
    log_a = log_a.reshape(B, L, GLA_HEADS, GLA_DK)
    o, s_fin = gla_recurrence(q, k, v, log_a, s0)
    o = rmsnorm(o.astype(h.dtype), g_norm).reshape(B, L, GLA_VW) * jax.nn.silu(g)
    return o @ w_out, s_fin.astype(s0.dtype)


def mla_attend(q_lat, q_pe, ckv, kpe, q_pos, k_pos):
    s = jnp.einsum('bqhc,bkc->bhqk', q_lat, ckv) + jnp.einsum('bqhr,bkr->bhqk', q_pe, kpe)
    s = s.astype(jnp.float32) * MLA_SCALE
    visible = (k_pos[None, :] // CHUNK) <= (q_pos[:, None] // CHUNK)
    s = jnp.where(visible, s, -jnp.inf)
    p = jax.nn.softmax(s, axis=-1).astype(ckv.dtype)
    return jnp.einsum('bhqk,bkc->bqhc', p, ckv)


def mla_mixer(h, pos, past_ckv, past_kpe, past_pos, w_down, q_norm, w_uq, kv_norm, w_uk, w_uv, w_out):
    B, L, _ = h.shape
    cq, ckv_raw, kpe_raw = jnp.split(h @ w_down, [MLA_Q_LORA, MLA_Q_LORA + MLA_KV_LORA], axis=-1)
    q = (rmsnorm(cq, q_norm) @ w_uq).reshape(B, L, MLA_HEADS, MLA_NOPE + MLA_ROPE)
    q_nope, q_pe = jnp.split(q, [MLA_NOPE], axis=-1)
    q_pe = rope(q_pe, pos)
    ckv_new = rmsnorm(ckv_raw, kv_norm)
    kpe_new = rope(kpe_raw, pos)
    q_lat = jnp.einsum('bqhd,chd->bqhc', q_nope, w_uk)
    if past_ckv is None:
        ckv, kpe, k_pos = ckv_new, kpe_new, pos
    else:
        ckv = jnp.concatenate([past_ckv, ckv_new], axis=1)
        kpe = jnp.concatenate([past_kpe, kpe_new], axis=1)
        k_pos = jnp.concatenate([past_pos, pos])
    if L > Q_BLOCK:
        nb = L // Q_BLOCK
        qb = q_lat.reshape(B, nb, Q_BLOCK, MLA_HEADS, MLA_KV_LORA).swapaxes(0, 1)
        pb = q_pe.reshape(B, nb, Q_BLOCK, MLA_HEADS, MLA_ROPE).swapaxes(0, 1)
        posb = pos.reshape(nb, Q_BLOCK)
        o_lat = lax.map(lambda a: mla_attend(a[0], a[1], ckv, kpe, a[2], k_pos), (qb, pb, posb))
        o_lat = o_lat.swapaxes(0, 1).reshape(B, L, MLA_HEADS, MLA_KV_LORA)
    else:
        o_lat = mla_attend(q_lat, q_pe, ckv, kpe, pos, k_pos)
    o = jnp.einsum('bqhc,chv->bqhv', o_lat, w_uv).reshape(B, L, MLA_HEADS * MLA_V)
    return o @ w_out, ckv_new, kpe_new


def setup_inputs(seed: int = 0) -> dict:
    key = jax.random.key(seed)
    ks = iter(jax.random.split(key, 32))

    def w(shape, fan_in):
        return jax.random.normal(next(ks), shape, jnp.float32) * (fan_in ** -0.5)

    def gain(shape):
        return 1.0 + 0.02 * jax.random.normal(next(ks), shape, jnp.float32)

    D, F = D_MODEL, D_FF
    return {
        'x_prompt': jax.random.normal(next(ks), (BATCH, SEQ, D), jnp.float32),
        'x_sample': jax.random.normal(next(ks), (DEC_BATCH, DEC_SEQ, D), jnp.float32),
        'state_gla': w((N_GLA_LAYERS, DEC_BATCH, GLA_HEADS, GLA_DK, GLA_DV), GLA_DK),
        'cache_ckv': jax.random.normal(next(ks), (N_MLA_LAYERS, DEC_BATCH, PAST_LEN, MLA_KV_LORA), jnp.float32),
        'cache_kpe': jax.random.normal(next(ks), (N_MLA_LAYERS, DEC_BATCH, PAST_LEN, MLA_ROPE), jnp.float32),
        'norm_ffn1': gain((DEPTH, D)),
        'w_ffn1_gate': w((DEPTH, D, F), D),
        'w_ffn1_up': w((DEPTH, D, F), D),
        'w_ffn1_down': w((DEPTH, F, D), F),
        'norm_mix': gain((DEPTH, D)),
        'norm_ffn2': gain((DEPTH, D)),
        'w_ffn2_gate': w((DEPTH, D, F), D),
        'w_ffn2_up': w((DEPTH, D, F), D),
        'w_ffn2_down': w((DEPTH, F, D), F),
        'w_gla_in': w((N_GLA_LAYERS, D, GLA_IN), D),
        'w_gla_gk_up': w((N_GLA_LAYERS, GLA_GATE_RANK, GLA_QK), GLA_GATE_RANK),
        'b_gla_gk': 0.1 * jax.random.normal(next(ks), (N_GLA_LAYERS, GLA_QK), jnp.float32),
        'gla_out_norm': gain((N_GLA_LAYERS, GLA_DV)),
        'w_gla_out': w((N_GLA_LAYERS, GLA_VW, D), GLA_VW),
        'w_mla_down': w((N_MLA_LAYERS, D, MLA_DOWN), D),
        'mla_q_norm': gain((N_MLA_LAYERS, MLA_Q_LORA)),
        'w_mla_uq': w((N_MLA_LAYERS, MLA_Q_LORA, MLA_HEADS * (MLA_NOPE + MLA_ROPE)), MLA_Q_LORA),
        'mla_kv_norm': gain((N_MLA_LAYERS, MLA_KV_LORA)),
        'w_mla_uk': w((N_MLA_LAYERS, MLA_KV_LORA, MLA_HEADS, MLA_NOPE), MLA_KV_LORA),
        'w_mla_uv': w((N_MLA_LAYERS, MLA_KV_LORA, MLA_HEADS, MLA_V), MLA_KV_LORA),
        'w_mla_out': w((N_MLA_LAYERS, MLA_HEADS * MLA_V, D), MLA_HEADS * MLA_V),
        'norm_final': gain((D,)),
    }


def reference(x_prompt, x_sample, state_gla, cache_ckv, cache_kpe,
              norm_ffn1, w_ffn1_gate, w_ffn1_up, w_ffn1_down, norm_mix,
              norm_ffn2, w_ffn2_gate, w_ffn2_up, w_ffn2_down,
              w_gla_in, w_gla_gk_up, b_gla_gk, gla_out_norm, w_gla_out,
              w_mla_down, mla_q_norm, w_mla_uq, mla_kv_norm, w_mla_uk, w_mla_uv, w_mla_out,
              norm_final):

    def run(x, pos, gla_s0, past_ckv, past_kpe, past_pos):
        new_gla, new_ckv, new_kpe = [], [], []
        for i in range(DEPTH):
            x = x + 0.5 * swiglu(rmsnorm(x, norm_ffn1[i]), w_ffn1_gate[i], w_ffn1_up[i], w_ffn1_down[i])
            h = rmsnorm(x, norm_mix[i])
            j = i // N_MIXERS
            if i % N_MIXERS == 0:
                y, s = gla_mixer(h, gla_s0[j], w_gla_in[j], w_gla_gk_up[j], b_gla_gk[j],
                                 gla_out_norm[j], w_gla_out[j])
                new_gla.append(s)
            else:
                pc = None if past_ckv is None else past_ckv[j]
                pk = None if past_kpe is None else past_kpe[j]
                y, c, r = mla_mixer(h, pos, pc, pk, past_pos, w_mla_down[j], mla_q_norm[j], w_mla_uq[j],
                                    mla_kv_norm[j], w_mla_uk[j], w_mla_uv[j], w_mla_out[j])
                new_ckv.append(c)
                new_kpe.append(r)
            x = x + y
            x = x + 0.5 * swiglu(rmsnorm(x, norm_ffn2[i]), w_ffn2_gate[i], w_ffn2_up[i], w_ffn2_down[i])
        return rmsnorm(x, norm_final), jnp.stack(new_gla), jnp.stack(new_ckv), jnp.stack(new_kpe)

    bp, lp = x_prompt.shape[0], x_prompt.shape[1]
    pos_p = jnp.arange(lp)
    s0_p = jnp.zeros((N_GLA_LAYERS, bp, GLA_HEADS, GLA_DK, GLA_DV), x_prompt.dtype)
    y_prompt, gla_p, ckv_p, kpe_p = run(x_prompt, pos_p, s0_p, None, None, None)

    past_len = cache_ckv.shape[2]
    pos_s = past_len + jnp.arange(x_sample.shape[1])
    past_pos = jnp.arange(past_len)
    y_sample, gla_s, ckv_s, kpe_s = run(x_sample, pos_s, state_gla, cache_ckv, cache_kpe, past_pos)

    return (y_prompt, y_sample, gla_p, ckv_p, kpe_p, gla_s, ckv_s, kpe_s)
```

```cpp
#include <hip/hip_runtime.h>
#include <hip/hip_cooperative_groups.h>
#include <cstdio>
#include <cstdint>
namespace cg = cooperative_groups;

#ifndef ONE_LAUNCH
#define ONE_LAUNCH 1
#endif

namespace pg8 {
#define PG8_LAS __attribute__((address_space(3)))
typedef unsigned short bf16_t;
typedef short bf16x8 __attribute__((ext_vector_type(8)));
typedef float f32x4 __attribute__((ext_vector_type(4)));
typedef unsigned u32x4 __attribute__((ext_vector_type(4)));
constexpr int BM = 256, BK = 64, HALF = 128, HTB = HALF * BK * 2  , STAGE_BYTES = 8 * HTB, NXCD = 8, WGM = 8;

__host__ __device__ __forceinline__ int lds_byte(int r, int c) { const int st = (r >> 4) * 2 + (c >> 5), rr = r & 15, cc = c & 31, ob = rr * 64 + cc * 2; return st * 1024 + (ob ^ (((ob >> 9) & 1) << 5)); }
__host__ __device__ __forceinline__ void stage_rc(int b, int& R, int& C) { const int st = b / 1024, sb = b % 1024, swz = sb ^ (((sb >> 9) & 1) << 5); R = (st >> 1) * 16 + swz / 64; C = (st & 1) * 32 + (swz % 64) / 2; }
__host__ __device__ __forceinline__ int perm32(int rho) { const int n = rho >> 4, i = rho & 15; return 8 * (i >> 2) + 4 * n + (i & 3); }

struct Unit { int pm, pn, k0, nt, part; };
struct Gemm { const bf16_t* A; const bf16_t* Bt; int M, N, K; };

struct StaticOrder {
    int nM, nN, nwg, G, c;
    int ntK;
    __host__ __device__ void init(int M, int N, int K, int G_, int c_) { nM = M / BM; nN = N / BM; nwg = nM * nN; G = G_; c = c_; ntK = K / BK; }
    __host__ __device__ bool next(int i, Unit& u) const {
        const long L = (long)i * G + c; if (L >= nwg) return false;
        int wgid = (int)L; { const int q = nwg / NXCD, r = nwg % NXCD, xcd = wgid % NXCD, off = wgid / NXCD; wgid = (xcd < r ? xcd * (q + 1) : r * (q + 1) + (xcd - r) * q) + off; }
        const int nig = WGM * nN, gid = wgid / nig, fm = gid * WGM, gsz = (nM - fm) < WGM ? (nM - fm) : WGM;
        u.pm = fm + ((wgid % nig) % gsz); u.pn = (wgid % nig) / gsz; u.k0 = 0; u.nt = ntK; u.part = -1; return true;
    }
    __device__ __forceinline__ void a_ready(const Unit&) const {}
    __device__ __forceinline__ void done(const Unit&) const {}
};

struct SplitOrder {
    StaticOrder full; int G, c, ntK; bool split;
    __host__ __device__ void init(int M, int N, int K, int G_, int c_) { G = G_; c = c_; ntK = K / BK; split = (G_ == 256 && N == 1024 && M == 34816); full.init(split ? 32768 : M, N, K, G_, c_); }
    __host__ __device__ bool next(int i, Unit& u) const {
        if (!split) return full.next(i, u);
        if (i < 2) return full.next(i, u);
        if (i > 2) return false;
        const int ru = c >> 3, part = c & 7, np = ntK >> 1; const int p0 = part * np / 8, p1 = (part + 1) * np / 8;
        u.pm = 128 + (ru >> 2); u.pn = ru & 3; u.k0 = 2 * p0; u.nt = 2 * (p1 - p0); u.part = part; return true;
    }
    __device__ __forceinline__ void a_ready(const Unit&) const {}
    __device__ __forceinline__ void done(const Unit&) const {}
};

__device__ __forceinline__ unsigned cvt_pk_bf16(float lo, float hi) { unsigned r; asm volatile("v_cvt_pk_bf16_f32 %0, %1, %2" : "=v"(r) : "v"(lo), "v"(hi)); return r; }
typedef float f32x2 __attribute__((ext_vector_type(2)));
template <class Epi, class Sched, bool ALIGN_EPI = false, bool SP2 = false>
__device__ __forceinline__ void gemm_phase(PG8_LAS unsigned char* lds, const Gemm g, const Sched& S, const Epi& E) {
    const int tid = threadIdx.x, wid = __builtin_amdgcn_readfirstlane(tid >> 6), lane = tid & 63, wr = wid >> 2, wc = wid & 3, fr = lane & 15, fq = lane >> 4;
    const int K = g.K;
    unsigned voffA[2], voffB[2];
#pragma unroll
    for (int i = 0; i < 2; ++i) { int R, C; stage_rc(tid * 16 + i * 8192, R, C); const int Rb = Epi::PERM ? ((R & ~31) + perm32(R & 31)) : R;
        voffA[i] = (unsigned)(R * K + C) * 2u; voffB[i] = (unsigned)(Rb * K + C) * 2u; }
    const size_t kstep = (size_t)(BK * 2);
    const size_t hstep = (size_t)HALF * K * 2;
    const size_t tstep = 2 * hstep;
    const unsigned ldsw = (unsigned)wid * 1024u;
    const int aoff = lds_byte(wr * 64 + fr, fq * 8), boff = lds_byte(wc * 32 + fr, fq * 8);
#define PG8_SA(b, h) (((b) * 2 + (h)) * HTB)
#define PG8_SB(b, h) ((4 + (b) * 2 + (h)) * HTB)
#define PG8_STAGE(bufoff, gbase, voff) do { _Pragma("unroll") for (int _i = 0; _i < 2; ++_i) \
        __builtin_amdgcn_global_load_lds((const unsigned*)((const char*)(gbase) + (voff)[_i]), (PG8_LAS unsigned*)(lds + (bufoff) + ldsw + _i * 8192), 16, 0, 0); } while (0)
#define PG8_LDA(dst, b, h) do { _Pragma("unroll") for (int m = 0; m < 4; ++m) _Pragma("unroll") for (int k = 0; k < 2; ++k) dst[m][k] = *(const PG8_LAS bf16x8*)(lds + PG8_SA(b, h) + aoff + m * 2048 + k * 1024); } while (0)
#define PG8_LDB(dst, b, h) do { _Pragma("unroll") for (int n = 0; n < 2; ++n) _Pragma("unroll") for (int k = 0; k < 2; ++k) dst[n][k] = *(const PG8_LAS bf16x8*)(lds + PG8_SB(b, h) + boff + n * 2048 + k * 1024); } while (0)
#define PG8_MMA(ai, bj, At, Bt) do { __builtin_amdgcn_s_setprio(1); _Pragma("unroll") for (int m = 0; m < 4; ++m) _Pragma("unroll") for (int n = 0; n < 2; ++n) _Pragma("unroll") for (int k = 0; k < 2; ++k) \
        acc[ai][bj][m][n] = __builtin_amdgcn_mfma_f32_16x16x32_bf16(Bt[n][k], At[m][k], acc[ai][bj][m][n], 0, 0, 0); __builtin_amdgcn_s_setprio(0); } while (0)
#define PG8_WAIT_V(n) asm volatile("s_waitcnt vmcnt(" #n ")" ::: "memory")
#define PG8_WAIT_L(n) asm volatile("s_waitcnt lgkmcnt(" #n ")" ::: "memory")
#define PG8_BAR __builtin_amdgcn_s_barrier()
#define PG8_SCHED __builtin_amdgcn_sched_barrier(0)
    Unit cur, nxt; int ui = 0;
    if (!S.next(0, cur)) return;
    float er[8];
#pragma unroll
    for (int i = 0; i < 8; ++i) er[i] = 0.f;
    f32x4 acc[2][2][4][2];
#pragma unroll
    for (int a = 0; a < 2; ++a)
#pragma unroll
        for (int b = 0; b < 2; ++b)
#pragma unroll
            for (int m = 0; m < 4; ++m)
#pragma unroll
                for (int n = 0; n < 2; ++n) acc[a][b][m][n] = (f32x4){0.f, 0.f, 0.f, 0.f};
    bf16x8 At[4][2], B0[2][2], B1[2][2];
    const char* cA = (const char*)g.A + (size_t)cur.pm * tstep + (size_t)cur.k0 * kstep; const char* cB = (const char*)g.Bt + (size_t)cur.pn * tstep + (size_t)cur.k0 * kstep;
    S.a_ready(cur);
    if constexpr (SP2) {
        PG8_STAGE(PG8_SB(0, 0), cB, voffB); PG8_STAGE(PG8_SB(0, 1), cB + hstep, voffB); PG8_STAGE(PG8_SA(0, 0), cA, voffA); PG8_STAGE(PG8_SA(0, 1), cA + hstep, voffA);
        if (wr == 1) PG8_BAR;
        PG8_WAIT_V(2); PG8_BAR;
        PG8_STAGE(PG8_SB(1, 0), cB + kstep, voffB); PG8_STAGE(PG8_SA(1, 0), cA + kstep, voffA); PG8_STAGE(PG8_SB(1, 1), cB + hstep + kstep, voffB);
        PG8_WAIT_V(6); PG8_BAR;
    } else {
        PG8_STAGE(PG8_SB(0, 0), cB, voffB); PG8_STAGE(PG8_SA(0, 0), cA, voffA); PG8_STAGE(PG8_SB(0, 1), cB + hstep, voffB); PG8_STAGE(PG8_SA(0, 1), cA + hstep, voffA);
        if (wr == 1) PG8_BAR;
        PG8_WAIT_V(4); PG8_BAR;
        PG8_STAGE(PG8_SB(1, 0), cB + kstep, voffB); PG8_STAGE(PG8_SA(1, 0), cA + kstep, voffA); PG8_STAGE(PG8_SB(1, 1), cB + hstep + kstep, voffB);
        PG8_WAIT_V(6); PG8_BAR;
    }
    for (;;) {
        const bool has_next = S.next(ui + 1, nxt);
        const char* nA = has_next ? (const char*)g.A + (size_t)nxt.pm * tstep + (size_t)nxt.k0 * kstep : cA; const char* nB = has_next ? (const char*)g.Bt + (size_t)nxt.pn * tstep + (size_t)nxt.k0 * kstep : cB;
        const int nt = cur.nt;
_Pragma("nounroll")
        for (int t = 0; t < nt; t += 2) {
            const bool last = (t == nt - 2);
            if (last) E.preload(er, cur, wr, fr);
            const char* a1 = cA + (size_t)(t + 1) * kstep;
            const char* a2 = last ? nA : cA + (size_t)(t + 2) * kstep; const char* b2 = last ? nB : cB + (size_t)(t + 2) * kstep;
            const char* a3 = a2 + kstep; const char* b3 = b2 + kstep;
            if (last && has_next) S.a_ready(nxt);
            if constexpr (SP2) {
            PG8_LDB(B0, 0, 0); PG8_LDB(B1, 0, 1); PG8_SCHED; PG8_LDA(At, 0, 0); PG8_STAGE(PG8_SA(1, 1), a1 + hstep, voffA);
            PG8_WAIT_V(8); PG8_WAIT_L(0); PG8_BAR; PG8_MMA(0, 0, At, B0); PG8_MMA(0, 1, At, B1); PG8_BAR; PG8_SCHED;
            PG8_LDA(At, 0, 1); PG8_STAGE(PG8_SB(0, 0), b2, voffB); PG8_STAGE(PG8_SB(0, 1), b2 + hstep, voffB); PG8_STAGE(PG8_SA(0, 0), a2, voffA);
            PG8_WAIT_V(8); PG8_WAIT_L(0); PG8_BAR; PG8_MMA(1, 0, At, B0); PG8_MMA(1, 1, At, B1); PG8_BAR; PG8_SCHED;
            PG8_LDB(B0, 1, 0); PG8_LDB(B1, 1, 1); PG8_SCHED; PG8_LDA(At, 1, 0); PG8_STAGE(PG8_SA(0, 1), a2 + hstep, voffA);
            PG8_WAIT_V(8); PG8_WAIT_L(0); PG8_BAR; PG8_MMA(0, 0, At, B0); PG8_MMA(0, 1, At, B1); PG8_BAR; PG8_SCHED;
            PG8_LDA(At, 1, 1); PG8_STAGE(PG8_SB(1, 0), b3, voffB); PG8_STAGE(PG8_SB(1, 1), b3 + hstep, voffB); PG8_STAGE(PG8_SA(1, 0), a3, voffA);
            PG8_WAIT_V(8); PG8_WAIT_L(0); PG8_BAR; PG8_MMA(1, 0, At, B0); PG8_MMA(1, 1, At, B1); PG8_BAR; PG8_SCHED;
            } else {
            PG8_LDB(B0, 0, 0); PG8_SCHED; PG8_LDA(At, 0, 0); PG8_STAGE(PG8_SA(1, 1), a1 + hstep, voffA);
            PG8_WAIT_L(8); PG8_BAR; PG8_WAIT_L(0); PG8_MMA(0, 0, At, B0); PG8_BAR; PG8_SCHED;
            PG8_LDB(B1, 0, 1); PG8_STAGE(PG8_SB(0, 0), b2, voffB);
            PG8_BAR; PG8_WAIT_L(0); PG8_MMA(0, 1, At, B1); PG8_BAR;
            PG8_LDA(At, 0, 1); PG8_STAGE(PG8_SA(0, 0), a2, voffA);
            PG8_BAR; PG8_WAIT_L(0); PG8_MMA(1, 0, At, B0); PG8_BAR; PG8_SCHED;
            PG8_STAGE(PG8_SB(0, 1), b2 + hstep, voffB);
            PG8_WAIT_V(6); PG8_BAR; PG8_MMA(1, 1, At, B1); PG8_BAR;
            PG8_LDB(B0, 1, 0); PG8_SCHED; PG8_LDA(At, 1, 0); PG8_STAGE(PG8_SA(0, 1), a2 + hstep, voffA);
            PG8_WAIT_L(8); PG8_BAR; PG8_WAIT_L(0); PG8_MMA(0, 0, At, B0); PG8_BAR; PG8_SCHED;
            PG8_LDB(B1, 1, 1); PG8_STAGE(PG8_SB(1, 0), b3, voffB);
            PG8_BAR; PG8_WAIT_L(0); PG8_MMA(0, 1, At, B1); PG8_BAR;
            PG8_LDA(At, 1, 1); PG8_STAGE(PG8_SA(1, 0), a3, voffA);
            PG8_BAR; PG8_WAIT_L(0); PG8_MMA(1, 0, At, B0); PG8_BAR; PG8_SCHED;
            PG8_STAGE(PG8_SB(1, 1), b3 + hstep, voffB);
            PG8_WAIT_V(6); PG8_BAR; PG8_MMA(1, 1, At, B1); PG8_BAR;
            }
        }
        if constexpr (ALIGN_EPI) { if (wr == 0) PG8_BAR; }
        if constexpr (!Epi::AFTER_DRAIN) { E(acc, cur, wr, wc, fr, fq, er); S.done(cur); }
        if (!has_next) break;
#pragma unroll
        for (int a = 0; a < 2; ++a)
#pragma unroll
            for (int b = 0; b < 2; ++b)
#pragma unroll
                for (int m = 0; m < 4; ++m)
#pragma unroll
                    for (int n = 0; n < 2; ++n) acc[a][b][m][n] = (f32x4){0.f, 0.f, 0.f, 0.f};
        cur = nxt; cA = nA; cB = nB; ++ui;
        if constexpr (ALIGN_EPI) { if (wr == 1) PG8_BAR; }
    }
    PG8_WAIT_V(0);
    if constexpr (!ALIGN_EPI) { if (wr == 0) PG8_BAR; }
    PG8_BAR;
    if constexpr (Epi::AFTER_DRAIN) { E.fused(acc, cur, wr, wc, fr, fq, lds, wid, lane); S.done(cur); }
#undef PG8_SA
#undef PG8_SB
#undef PG8_STAGE
#undef PG8_LDA
#undef PG8_LDB
#undef PG8_MMA
#undef PG8_WAIT_V
#undef PG8_WAIT_L
#undef PG8_BAR
#undef PG8_SCHED
}
}

#define GAS __attribute__((address_space(1)))
#define LAS __attribute__((address_space(3)))
typedef unsigned short bf16;
typedef float f32x4 __attribute__((ext_vector_type(4)));
typedef float f32x2 __attribute__((ext_vector_type(2)));
typedef float f32x16 __attribute__((ext_vector_type(16)));
typedef short bf16x8 __attribute__((ext_vector_type(8)));
typedef short s16x4 __attribute__((ext_vector_type(4)));
typedef unsigned u32x4 __attribute__((ext_vector_type(4)));
typedef unsigned u32x2 __attribute__((ext_vector_type(2)));

constexpr int NWAVES = 8, NTHR = 512;
constexpr int D = 1024, FF = 2816, TP = 32768, TS = 2048, T = TP + TS;
constexpr int SEQ = 8192, NB = 4, DB = 32, DSEQ = 64, PAST = 1024, KSEQS = PAST + DSEQ;
constexpr int TK = TP + DB * KSEQS;
constexpr float EPS = 1e-6f;
constexpr int GLA_NPROJ = 3072, GLA_N = 3584;
constexpr int NSLOT = 1088;
constexpr float QSCALE = 0.07216878364870322f * 1.4426950408889634f;

constexpr size_t O_Y = 0, O_GLAP = 35651584, O_CKVP = 36175872, O_KPEP = 44564480, O_GLAS = 46661632, O_CKVS = 50855936, O_KPES = 51380224;
constexpr size_t MiB = 1u << 20;
constexpr size_t WS_CTL = 0, WS_ROPE = 1 * MiB, WS_DEC = 3 * MiB, WS_W = 4 * MiB, WS_HB = 88 * MiB, WS_US = 156 * MiB, WS_BIG = 224 * MiB, WS_END = 462 * MiB;
constexpr size_t W1T_B = (size_t)2 * FF * D * 2, W2T_B = (size_t)D * FF * 2, FFN_B = W1T_B + W2T_B;
constexpr size_t WO_FFN = 0, WO_GLAIN = 4 * FFN_B, WO_GLAOUT = WO_GLAIN + (size_t)GLA_N * D * 2, WO_DOWN = WO_GLAOUT + (size_t)D * D * 2,
                 WO_UQ = WO_DOWN + (size_t)768 * D * 2, WO_KVUP = WO_UQ + (size_t)1536 * 384 * 2, WO_MLAOUT = WO_KVUP + (size_t)2 * 1024 * 256 * 2, WO_END = WO_MLAOUT + (size_t)D * D * 2;
static_assert(WO_END <= 84 * MiB, "weights");
constexpr size_t US_CQN = 0, US_CKVN = (size_t)T * 384 * 2, US_KPEB = US_CKVN + (size_t)TK * 256 * 2;
static_assert(US_KPEB + (size_t)TK * 64 * 2 <= 68 * MiB, "US");
constexpr size_t BG_ACT = 0, BG_PROJ = 0, BG_LA = (size_t)T * GLA_NPROJ * 2, BG_DOWN = 0, BG_Q = 0, BG_KU = (size_t)T * 1536 * 2, BG_VU = BG_KU + (size_t)TK * 512 * 2;
static_assert(BG_VU + (size_t)TK * 512 * 2 <= 238 * MiB && BG_LA + (size_t)T * 512 * 2 <= 238 * MiB, "BIG");
constexpr size_t WS_BAR = 16 * 1024;
constexpr size_t WS_SSQ = 128 * 1024;
static_assert(WS_SSQ + (size_t)6 * T * 4 <= MiB, "ssq");
constexpr int LDS_BYTES = 160 * 1024;

__device__ __forceinline__ unsigned f2bf(float f) { unsigned u = __builtin_bit_cast(unsigned, f); return (u + 0x7fffu + ((u >> 16) & 1u)) >> 16; }
__device__ __forceinline__ unsigned pk2(float lo, float hi) { return pg8::cvt_pk_bf16(lo, hi); }
__device__ __forceinline__ float bf2f(bf16 b) { return __uint_as_float(((unsigned)b) << 16); }
__device__ __forceinline__ float wave_sum(float v) {
#pragma unroll
    for (int o = 1; o < 64; o <<= 1) v += __shfl_xor(v, o);
    return v;
}
__device__ __forceinline__ float fast_exp(float x) { return __builtin_amdgcn_exp2f(x * 1.4426950408889634f); }
__device__ __forceinline__ float silu_f(float g) { return g * __builtin_amdgcn_rcpf(1.0f + fast_exp(-g)); }
__device__ __forceinline__ int tok_pos(int row) { return row < TP ? (row & (SEQ - 1)) : PAST + ((row - TP) & (DSEQ - 1)); }
__device__ __forceinline__ int tok_keyrow(int row) { if (row < TP) return row; const int s = row - TP; return TP + (s >> 6) * KSEQS + PAST + (s & 63); }

__device__ __forceinline__ float rstd_of(float ssq) { return 1.0f / sqrtf(ssq * (1.f / D) + EPS); }
using pg8::Unit; using pg8::BM; using pg8::HALF;
struct EpiSwiglu {
    static constexpr bool PERM = true, AFTER_DRAIN = false;
    bf16* O; const float* ssq;
    __device__ __forceinline__ void preload(float (&er)[8], const Unit& u, int wr, int fr) const {
        const int row0 = u.pm * BM + wr * 64 + fr;
#pragma unroll
        for (int ai = 0; ai < 2; ++ai)
#pragma unroll
            for (int m = 0; m < 4; ++m) er[ai * 4 + m] = ((const GAS float*)ssq)[row0 + ai * HALF + m * 16];
    }
    __device__ __forceinline__ void operator()(const f32x4 (&acc)[2][2][4][2], const Unit& u, int wr, int wc, int fr, int fq, const float (&er)[8]) const {
        const int row0 = u.pm * BM + wr * 64 + fr, col0 = u.pn * 128 + wc * 32 + 8 * fq;
#pragma unroll
        for (int ai = 0; ai < 2; ++ai)
#pragma unroll
            for (int m = 0; m < 4; ++m) {
                const int row = row0 + ai * HALF + m * 16; const float r = rstd_of(er[ai * 4 + m]);
                bf16* rowp = O + (size_t)row * FF + col0;
                const f32x4 g0 = acc[ai][0][m][0] * r, g1 = acc[ai][0][m][1] * r, u0 = acc[ai][1][m][0] * r, u1 = acc[ai][1][m][1] * r;
                u32x4 w;
                w.x = pk2(silu_f(g0[0]) * u0[0], silu_f(g0[1]) * u0[1]); w.y = pk2(silu_f(g0[2]) * u0[2], silu_f(g0[3]) * u0[3]);
                w.z = pk2(silu_f(g1[0]) * u1[0], silu_f(g1[1]) * u1[1]); w.w = pk2(silu_f(g1[2]) * u1[2], silu_f(g1[3]) * u1[3]);
                *(u32x4*)rowp = w;
            }
    }
};
template <bool WXB, bool FIRST = false> struct EpiResid {
    static constexpr bool PERM = false, AFTER_DRAIN = false;
    float* X; float scale; float* P; bf16* XB; float* SSQ; const float* Xp; const float* Xs;
    __device__ __forceinline__ void preload(float (&)[8], const Unit&, int, int) const {}
    __device__ __forceinline__ void operator()(const f32x4 (&acc)[2][2][4][2], const Unit& u, int wr, int wc, int fr, int fq, const float (&er)[8]) const {
        const int row0 = u.pm * BM + wr * 64 + fr, col0 = u.pn * BM + wc * 32 + 4 * fq;
        if (u.part >= 0) {
#pragma unroll
            for (int ai = 0; ai < 2; ++ai)
#pragma unroll
                for (int m = 0; m < 4; ++m) {
                    float* rowp = P + ((size_t)u.part * TS + (size_t)(row0 + ai * HALF + m * 16 - TP)) * D + col0;
#pragma unroll
                    for (int bj = 0; bj < 2; ++bj)
#pragma unroll
                        for (int n = 0; n < 2; ++n) *(f32x4*)(rowp + bj * HALF + n * 16) = acc[ai][bj][m][n];
                }
            return;
        }
#pragma unroll
        for (int ai = 0; ai < 2; ++ai)
#pragma unroll
            for (int m = 0; m < 4; ++m) {
                const int row = row0 + ai * HALF + m * 16;
                float* rowp = X + (size_t)row * D + col0; float s = 0.f;
                const float* inp = FIRST ? ((row < TP ? Xp + (size_t)row * D : Xs + (size_t)(row - TP) * D) + col0) : rowp;
#pragma unroll
                for (int bj = 0; bj < 2; ++bj)
#pragma unroll
                    for (int n = 0; n < 2; ++n) { f32x4 v = *(const f32x4*)(inp + bj * HALF + n * 16); v += acc[ai][bj][m][n] * scale; *(f32x4*)(rowp + bj * HALF + n * 16) = v;
                        if constexpr (WXB) { s += (v.x * v.x + v.y * v.y) + (v.z * v.z + v.w * v.w); *(u32x2*)(XB + (size_t)row * D + col0 + bj * HALF + n * 16) = (u32x2){pk2(v.x, v.y), pk2(v.z, v.w)}; } }
                if constexpr (WXB) { s += __shfl_xor(s, 16); s += __shfl_xor(s, 32); if (fq == 0) atomicAdd(SSQ + row, s); }
            }
    }
};
struct EpiF32 {
    static constexpr bool PERM = false, AFTER_DRAIN = false;
    float* O; int ldc; const float* ssq;
    __device__ __forceinline__ void preload(float (&er)[8], const Unit& u, int wr, int fr) const {
        const int row0 = u.pm * BM + wr * 64 + fr;
#pragma unroll
        for (int ai = 0; ai < 2; ++ai)
#pragma unroll
            for (int m = 0; m < 4; ++m) er[ai * 4 + m] = ((const GAS float*)ssq)[row0 + ai * HALF + m * 16];
    }
    __device__ __forceinline__ void operator()(const f32x4 (&acc)[2][2][4][2], const Unit& u, int wr, int wc, int fr, int fq, const float (&er)[8]) const {
        const int row0 = u.pm * BM + wr * 64 + fr, col0 = u.pn * BM + wc * 32 + 4 * fq;
#pragma unroll
        for (int ai = 0; ai < 2; ++ai)
#pragma unroll
            for (int m = 0; m < 4; ++m) {
                const int row = row0 + ai * HALF + m * 16; const float r = rstd_of(er[ai * 4 + m]);
                float* rowp = O + (size_t)row * ldc + col0;
#pragma unroll
                for (int bj = 0; bj < 2; ++bj)
#pragma unroll
                    for (int n = 0; n < 2; ++n) *(f32x4*)(rowp + bj * HALF + n * 16) = acc[ai][bj][m][n] * r;
            }
    }
};
__device__ __forceinline__ float logsig16(float x) {
    const float ax = __builtin_fabsf(x);
    const float l = __builtin_amdgcn_logf(1.0f + fast_exp(-ax)) * 0.6931471805599453f;
    return (fminf(x, 0.f) - l) * 0.0625f;
}
struct EpiGlaIn {
    static constexpr bool PERM = true, AFTER_DRAIN = false;
    bf16* P; _Float16* LA; const float* bgk; const float* ssq;
    __device__ __forceinline__ void preload(float (&er)[8], const Unit& u, int wr, int fr) const {
        const int row0 = u.pm * BM + wr * 64 + fr;
#pragma unroll
        for (int ai = 0; ai < 2; ++ai)
#pragma unroll
            for (int m = 0; m < 4; ++m) er[ai * 4 + m] = ((const GAS float*)ssq)[row0 + ai * HALF + m * 16];
    }
    __device__ __forceinline__ void operator()(const f32x4 (&acc)[2][2][4][2], const Unit& u, int wr, int wc, int fr, int fq, const float (&er)[8]) const {
        const int row0 = u.pm * BM + wr * 64 + fr;
        if (u.pn < 12) {
            const int col0 = u.pn * BM + wc * 32 + 8 * fq;
#pragma unroll
            for (int ai = 0; ai < 2; ++ai)
#pragma unroll
                for (int m = 0; m < 4; ++m) {
                    const int row = row0 + ai * HALF + m * 16; const float r = rstd_of(er[ai * 4 + m]);
                    bf16* rowp = P + (size_t)row * GLA_NPROJ + col0;
#pragma unroll
                    for (int bj = 0; bj < 2; ++bj) { const f32x4 v0 = acc[ai][bj][m][0] * r, v1 = acc[ai][bj][m][1] * r; u32x4 w;
                        w.x = pk2(v0[0], v0[1]); w.y = pk2(v0[2], v0[3]); w.z = pk2(v1[0], v1[1]); w.w = pk2(v1[2], v1[3]); *(u32x4*)(rowp + bj * HALF) = w; }
                }
        } else {
            const int col0 = (u.pn - 12) * BM + wc * 32 + 8 * fq;
            f32x4 bv[2][2];
#pragma unroll
            for (int bj = 0; bj < 2; ++bj)
#pragma unroll
                for (int n = 0; n < 2; ++n) bv[bj][n] = *(const f32x4*)(bgk + col0 + bj * HALF + 4 * n);
#pragma unroll
            for (int ai = 0; ai < 2; ++ai)
#pragma unroll
                for (int m = 0; m < 4; ++m) {
                    const int row = row0 + ai * HALF + m * 16; const float r = rstd_of(er[ai * 4 + m]);
                    _Float16* rowp = LA + (size_t)row * 512 + col0;
#pragma unroll
                    for (int bj = 0; bj < 2; ++bj) {
                        const f32x4 v0 = acc[ai][bj][m][0] * r + bv[bj][0], v1 = acc[ai][bj][m][1] * r + bv[bj][1];
                        typedef _Float16 h8 __attribute__((ext_vector_type(8)));
                        h8 w; w[0] = (_Float16)logsig16(v0[0]); w[1] = (_Float16)logsig16(v0[1]); w[2] = (_Float16)logsig16(v0[2]); w[3] = (_Float16)logsig16(v0[3]);
                        w[4] = (_Float16)logsig16(v1[0]); w[5] = (_Float16)logsig16(v1[1]); w[6] = (_Float16)logsig16(v1[2]); w[7] = (_Float16)logsig16(v1[3]);
                        *(h8*)(rowp + bj * HALF) = w; }
                }
        }
    }
};
template <bool ROPE> struct EpiQ {
    static constexpr bool PERM = true, AFTER_DRAIN = false;
    bf16* Q; const f32x2* rope;
    __device__ __forceinline__ void preload(float (&)[8], const Unit&, int, int) const {}
    __device__ __forceinline__ void operator()(const f32x4 (&acc)[2][2][4][2], const Unit& u, int wr, int wc, int fr, int fq, const float (&er)[8]) const {
        const int row0 = u.pm * BM + wr * 64 + fr;
        if constexpr (!ROPE) {
#pragma unroll
            for (int ai = 0; ai < 2; ++ai)
#pragma unroll
                for (int m = 0; m < 4; ++m) {
                    bf16* rowp = Q + (size_t)(row0 + ai * HALF + m * 16) * 1536 + wc * 32 + 8 * fq;
#pragma unroll
                    for (int bj = 0; bj < 2; ++bj) { const f32x4 v0 = acc[ai][bj][m][0] * QSCALE, v1 = acc[ai][bj][m][1] * QSCALE; u32x4 w;
                        w.x = pk2(v0[0], v0[1]); w.y = pk2(v0[2], v0[3]); w.z = pk2(v1[0], v1[1]); w.w = pk2(v1[2], v1[3]); *(u32x4*)(rowp + (2 * u.pn + bj) * 192) = w; }
                }
        } else {
            const int head = u.pn * 4 + wc, i0 = 8 * fq;
#pragma unroll
            for (int ai = 0; ai < 2; ++ai)
#pragma unroll
                for (int m = 0; m < 4; ++m) {
                    const int row = row0 + ai * HALF + m * 16; const int pos = tok_pos(row);
                    const f32x2* rp = rope + (size_t)pos * 32 + i0;
                    bf16* qp = Q + (size_t)row * 1536 + head * 192 + 128 + i0;
#pragma unroll
                    for (int n = 0; n < 2; ++n) {
                        float o1[4], o2[4];
#pragma unroll
                        for (int e = 0; e < 4; ++e) { const f32x2 cs = rp[4 * n + e]; const float x1 = acc[ai][0][m][n][e], x2 = acc[ai][1][m][n][e];
                            o1[e] = (x1 * cs.x - x2 * cs.y) * QSCALE; o2[e] = (x1 * cs.y + x2 * cs.x) * QSCALE; }
                        *(u32x2*)(qp + 4 * n) = (u32x2){pk2(o1[0], o1[1]), pk2(o1[2], o1[3])};
                        *(u32x2*)(qp + 32 + 4 * n) = (u32x2){pk2(o2[0], o2[1]), pk2(o2[2], o2[3])};
                    }
                    asm volatile("" ::: "memory");
                }
        }
    }
};
struct EpiKV {
    static constexpr bool PERM = true, AFTER_DRAIN = false;
    bf16* KU; bf16* VU;
    __device__ __forceinline__ void preload(float (&)[8], const Unit&, int, int) const {}
    __device__ __forceinline__ void operator()(const f32x4 (&acc)[2][2][4][2], const Unit& u, int wr, int wc, int fr, int fq, const float (&er)[8]) const {
        const int row0 = u.pm * BM + wr * 64 + fr;
        bf16* base = (u.pn < 2) ? KU : VU; const int col0 = (u.pn & 1) * BM + wc * 32 + 8 * fq;
#pragma unroll
        for (int ai = 0; ai < 2; ++ai)
#pragma unroll
            for (int m = 0; m < 4; ++m) {
                bf16* rowp = base + (size_t)(row0 + ai * HALF + m * 16) * 512 + col0;
#pragma unroll
                for (int bj = 0; bj < 2; ++bj) { const f32x4 v0 = acc[ai][bj][m][0], v1 = acc[ai][bj][m][1]; u32x4 w;
                    w.x = pk2(v0[0], v0[1]); w.y = pk2(v0[2], v0[3]); w.z = pk2(v1[0], v1[1]); w.w = pk2(v1[2], v1[3]); *(u32x4*)(rowp + bj * HALF) = w; }
            }
    }
};

__device__ __forceinline__ s16x4 ds_tr(LAS const char* p) {
    typedef short v4i16_t __attribute__((ext_vector_type(4)));
    return __builtin_bit_cast(s16x4, __builtin_amdgcn_ds_read_tr16_b64_v4i16((LAS v4i16_t*)p));
}
__device__ __forceinline__ bf16x8 cat8(s16x4 a, s16x4 b) { return (bf16x8){a[0], a[1], a[2], a[3], b[0], b[1], b[2], b[3]}; }
#define MFMA32(a, b, c) __builtin_amdgcn_mfma_f32_32x32x16_bf16((a), (b), (c), 0, 0, 0)

struct Ctx {
    LAS unsigned char* lds; int tid, lane, wave, G, gw, NGW;
};
typedef const unsigned long long __attribute__((address_space(4)))* kargp_t;
__device__ __forceinline__ const float* KIN(int i) { return (const float*)((kargp_t)__builtin_amdgcn_kernarg_segment_ptr())[i]; }
__device__ __forceinline__ float* KOUT() { return (float*)((kargp_t)__builtin_amdgcn_kernarg_segment_ptr())[27]; }
__device__ __forceinline__ unsigned char* KWS() { return (unsigned char*)((kargp_t)__builtin_amdgcn_kernarg_segment_ptr())[28]; }

__device__ __forceinline__ void first_row(const Ctx& C, const float* xrow, bf16* orow, float* ssq) {
    const f32x4* xr = (const f32x4*)xrow + C.lane;
    f32x4 v[4]; float s = 0.f;
#pragma unroll
    for (int j = 0; j < 4; ++j) { v[j] = xr[64 * j]; s += (v[j].x * v[j].x + v[j].y * v[j].y) + (v[j].z * v[j].z + v[j].w * v[j].w); }
    s = wave_sum(s); if (C.lane == 0) *ssq = s;
    unsigned long long* o8 = (unsigned long long*)orow + C.lane;
#pragma unroll
    for (int j = 0; j < 4; ++j) o8[64 * j] = (unsigned long long)pk2(v[j].x, v[j].y) | ((unsigned long long)pk2(v[j].z, v[j].w) << 32);
}
__device__ __forceinline__ void add_partials(const Ctx& C, f32x4 (&v)[4], int m, const float* P, float pscale) {
#pragma unroll 2
    for (int p = 0; p < 8; ++p) { const f32x4* pr = (const f32x4*)(P + ((size_t)p * TS + (size_t)(m - TP)) * D) + C.lane;
#pragma unroll
        for (int j = 0; j < 4; ++j) v[j] += pr[64 * j] * pscale; }
}
__device__ __forceinline__ void fixup_phase(const Ctx& C, float* x, bf16* xb, float* ssq, const float* P, float pscale, const float* xs_in) {
    if (C.G != 256) return;
    for (int m = TP + C.gw; m < T; m += C.NGW) {
        f32x4* xr = (f32x4*)(x + (size_t)m * D) + C.lane; const f32x4* xi = xs_in ? (const f32x4*)(xs_in + (size_t)(m - TP) * D) + C.lane : xr;
        f32x4 v[4];
#pragma unroll
        for (int j = 0; j < 4; ++j) v[j] = xi[64 * j];
        add_partials(C, v, m, P, pscale);
        float s = 0.f;
#pragma unroll
        for (int j = 0; j < 4; ++j) { xr[64 * j] = v[j]; s += (v[j].x * v[j].x + v[j].y * v[j].y) + (v[j].z * v[j].z + v[j].w * v[j].w); }
        s = wave_sum(s); if (C.lane == 0) ssq[m] = s;
        unsigned long long* o8 = (unsigned long long*)(xb + (size_t)m * D) + C.lane;
#pragma unroll
        for (int j = 0; j < 4; ++j) o8[64 * j] = (unsigned long long)pk2(v[j].x, v[j].y) | ((unsigned long long)pk2(v[j].z, v[j].w) << 32);
    }
}
__device__ __forceinline__ void final_norm_phase(const Ctx& C, float* x, const float* g, const float* P, float pscale) {
    const bool split = (C.G == 256);
    for (int m = C.gw; m < T; m += C.NGW) {
        f32x4* xr = (f32x4*)(x + (size_t)m * D) + C.lane; const f32x4* gr = (const f32x4*)g + C.lane;
        f32x4 v[4]; float s = 0.f;
#pragma unroll
        for (int j = 0; j < 4; ++j) v[j] = xr[64 * j];
        if (split && m >= TP) add_partials(C, v, m, P, pscale);
#pragma unroll
        for (int j = 0; j < 4; ++j) s += (v[j].x * v[j].x + v[j].y * v[j].y) + (v[j].z * v[j].z + v[j].w * v[j].w);
        const float rstd = 1.0f / sqrtf(wave_sum(s) * (1.f / D) + EPS);
#pragma unroll
        for (int j = 0; j < 4; ++j) xr[64 * j] = v[j] * rstd * gr[64 * j];
    }
}

__device__ __forceinline__ void tr_item(const float* W, int ldw, int k0, bf16* WT, int Kd, int dst_row0, LAS float* scr, int lane, const float* gain) {
#pragma unroll 16
    for (int i = 0; i < 32; ++i) { const int kk = 2 * i + (lane >> 5); float v = W[(size_t)(k0 + kk) * ldw + (lane & 31)]; if (gain) v *= gain[k0 + kk]; scr[kk * 33 + (lane & 31)] = v; }
    asm volatile("s_waitcnt lgkmcnt(0)" ::: "memory");
    const int c = lane & 7;
#pragma unroll
    for (int j = 0; j < 4; ++j) { const int n = (lane >> 3) + 8 * j; const LAS float* s = scr + (8 * c) * 33 + n;
        u32x4 o; o.x = pk2(s[0 * 33], s[1 * 33]); o.y = pk2(s[2 * 33], s[3 * 33]); o.z = pk2(s[4 * 33], s[5 * 33]); o.w = pk2(s[6 * 33], s[7 * 33]);
        *(u32x4*)(WT + (size_t)(dst_row0 + n) * Kd + k0 + 8 * c) = o; }
    asm volatile("s_waitcnt lgkmcnt(0)" ::: "memory");
}
enum { MAP_ID = 0, MAP_GATE = 1, MAP_UP = 2, MAP_UQ = 3, MAP_UK = 4, MAP_UV = 5 };
__device__ __forceinline__ int map_row(int map, int n) {
    switch (map) {
        case MAP_GATE: return 256 * (n >> 7) + (n & 127);
        case MAP_UP:   return 256 * (n >> 7) + 128 + (n & 127);
        case MAP_UQ: { const int h = n / 192, d = n - h * 192;
            if (d < 128) return h * 128 + d;
            if (d < 160) return 1024 + (h >> 2) * 256 + (h & 3) * 32 + (d - 128);
            return 1024 + (h >> 2) * 256 + 128 + (h & 3) * 32 + (d - 160); }
        case MAP_UK: { const int h = n >> 7, d = n & 127; return (h >> 2) * 1024 + (h & 3) * 128 + d; }
        case MAP_UV: { const int h = n >> 7, d = n & 127; return (h >> 2) * 1024 + 512 + (h & 3) * 128 + d; }
        default: return n;
    }
}
__device__ __forceinline__ bool tr_job(int& it, const float* W, int ldw, int K, int ncols, bf16* WT, int Kd, int map, LAS float* scr, int lane, const float* gain = nullptr) {
    const int nblk = ncols >> 5, items = (K >> 6) * nblk;
    if (it >= items) { it -= items; return false; }
    const int kb = it / nblk, nb = it - kb * nblk;
    tr_item(W + nb * 32, ldw, kb * 64, WT, Kd, map_row(map, nb * 32), scr, lane, gain);
    return true;
}

__constant__ double c_invfreq[32] = {1.0, 0.7498942093324559, 0.5623413251903491, 0.4216965034285822, 0.31622776601683794, 0.23713737056616552, 0.1778279410038923, 0.1333521432163324, 0.1,
    0.07498942093324558, 0.05623413251903491, 0.042169650342858224, 0.03162277660168379, 0.023713737056616554, 0.01778279410038923, 0.01333521432163324, 0.01, 0.007498942093324558,
    0.005623413251903491, 0.004216965034285823, 0.0031622776601683794, 0.0023713737056616554, 0.0017782794100389228, 0.001333521432163324, 0.001, 0.0007498942093324559, 0.0005623413251903491,
    0.00042169650342858224, 0.00031622776601683794, 0.00023713737056616554, 0.00017782794100389227, 0.0001333521432163324};

constexpr int I_W1 = (D / 64) * (FF / 32), I_W2 = (FF / 64) * (D / 32), I_FFN = 2 * I_W1 + I_W2;
constexpr int I_GLAIN = (D / 64) * (GLA_NPROJ / 32), I_SQ = (D / 64) * (D / 32), I_DOWN = (D / 64) * (704 / 32), I_UQ = (384 / 64) * (1536 / 32), I_UKV = (256 / 64) * (1024 / 32);
constexpr int N_EARLY = I_FFN + I_GLAIN, NITEMS = 4 * I_FFN + I_GLAIN + I_SQ + I_DOWN + I_UQ + 2 * I_UKV + I_SQ;
__device__ __forceinline__ void tr_dispatch(int it, LAS float* scr, int lane) {
    unsigned char* wsW = KWS() + WS_W;
    bool done = false;
    { const float* gn = KIN(5);
      done = tr_job(it, KIN(6), FF, D, FF, (bf16*)(wsW + WO_FFN), D, MAP_GATE, scr, lane, gn);
      if (!done) done = tr_job(it, KIN(7), FF, D, FF, (bf16*)(wsW + WO_FFN), D, MAP_UP, scr, lane, gn);
      if (!done) done = tr_job(it, KIN(8), D, FF, D, (bf16*)(wsW + WO_FFN + W1T_B), FF, MAP_ID, scr, lane); }
    if (!done) done = tr_job(it, KIN(14), 3088, D, GLA_NPROJ, (bf16*)(wsW + WO_GLAIN), D, MAP_ID, scr, lane, KIN(9));
    if (!done) done = tr_job(it, KIN(18), D, D, D, (bf16*)(wsW + WO_GLAOUT), D, MAP_ID, scr, lane);
#pragma unroll 1
    for (int f = 1; f < 4 && !done; ++f) {
        const int layer = f >> 1, second = f & 1;
        const float* wg = (second ? KIN(11) : KIN(6)) + (size_t)layer * D * FF; const float* wu = (second ? KIN(12) : KIN(7)) + (size_t)layer * D * FF; const float* wd = (second ? KIN(13) : KIN(8)) + (size_t)layer * FF * D;
        bf16* w1t = (bf16*)(wsW + WO_FFN + f * FFN_B); bf16* w2t = (bf16*)(wsW + WO_FFN + f * FFN_B + W1T_B);
        const float* gn = (second ? KIN(10) : KIN(5)) + (size_t)layer * D;
        done = tr_job(it, wg, FF, D, FF, w1t, D, MAP_GATE, scr, lane, gn);
        if (!done) done = tr_job(it, wu, FF, D, FF, w1t, D, MAP_UP, scr, lane, gn);
        if (!done) done = tr_job(it, wd, D, FF, D, w2t, FF, MAP_ID, scr, lane);
    }
    if (!done) done = tr_job(it, KIN(19), 704, D, 704, (bf16*)(wsW + WO_DOWN), D, MAP_ID, scr, lane, KIN(9) + D);
    if (!done) done = tr_job(it, KIN(21), 1536, 384, 1536, (bf16*)(wsW + WO_UQ), 384, MAP_UQ, scr, lane);
    if (!done) done = tr_job(it, KIN(23), 1024, 256, 1024, (bf16*)(wsW + WO_KVUP), 256, MAP_UK, scr, lane);
    if (!done) done = tr_job(it, KIN(24), 1024, 256, 1024, (bf16*)(wsW + WO_KVUP), 256, MAP_UV, scr, lane);
    if (!done) done = tr_job(it, KIN(25), D, D, D, (bf16*)(wsW + WO_MLAOUT), D, MAP_ID, scr, lane);
}
__device__ __forceinline__ void late_weights(const Ctx& C, int hf) {
    constexpr int N_LATE = NITEMS - N_EARLY, HALF_LATE = (N_LATE + 1) / 2;
    const int lo = N_EARLY + hf * HALF_LATE, hi = (hf == 0) ? N_EARLY + HALF_LATE : NITEMS;
    LAS float* scr = (LAS float*)(C.lds + C.wave * 16384);
    const int widx = blockIdx.x * 6 + (C.wave - 2), nw = C.G * 6;
    for (int it = lo + widx; it < hi; it += nw) tr_dispatch(it, scr, C.lane);
}

__device__ __forceinline__ void prologue(const Ctx& C) {
    unsigned char* wsW = KWS() + WS_W;
    LAS float* scr = (LAS float*)(C.lds + C.wave * 16384);
    if (blockIdx.x == 0) for (int i = C.tid; i < 1024; i += NTHR) ((unsigned*)(KWS() + WS_CTL))[i] = 0u;
#pragma unroll 1
    for (int step = 0; step < 2; ++step) {
        if ((step == 0) == (C.wave < 4)) {
            for (int it0 = C.gw; it0 < N_EARLY; it0 += C.NGW) tr_dispatch(it0, scr, C.lane);
        } else {
            for (int m = C.gw; m < T; m += C.NGW) {
                const float* src = (m < TP) ? KIN(0) + (size_t)m * D : KIN(1) + (size_t)(m - TP) * D;
                first_row(C, src, (bf16*)(KWS() + WS_HB) + (size_t)m * D, (float*)(KWS() + WS_SSQ) + m);
            }
        }
    }
    const int gt = C.gw * 64 + C.lane, NGT = C.NGW * 64;
    { float* z = (float*)(KWS() + WS_SSQ) + T; for (int i = gt; i < 5 * T; i += NGT) z[i] = 0.f; }
    { u32x4* z = (u32x4*)(wsW + WO_DOWN + (size_t)704 * D * 2); for (int i = gt; i < 64 * D * 2 / 16; i += NGT) z[i] = (u32x4){0u, 0u, 0u, 0u}; }
    { const float* win = KIN(14); const float* wup = KIN(15); bf16* dst = (bf16*)(wsW + WO_GLAIN) + (size_t)GLA_NPROJ * D;
      for (int i = gt; i < 512 * 128; i += NGT) { const int n = i >> 7, kc = (i & 127) * 8; float up[16];
#pragma unroll
          for (int r = 0; r < 16; ++r) up[r] = wup[r * 512 + n];
          float o[8];
#pragma unroll
          for (int j = 0; j < 8; ++j) { const f32x4* lr = (const f32x4*)(win + (size_t)(kc + j) * 3088 + 3072); float s = 0.f;
#pragma unroll
              for (int q = 0; q < 4; ++q) { const f32x4 v = lr[q]; s += v.x * up[4 * q] + v.y * up[4 * q + 1] + v.z * up[4 * q + 2] + v.w * up[4 * q + 3]; }
              o[j] = s * KIN(9)[kc + j]; }
          u32x4 w; w.x = pk2(o[0], o[1]); w.y = pk2(o[2], o[3]); w.z = pk2(o[4], o[5]); w.w = pk2(o[6], o[7]);
          *(u32x4*)(dst + (size_t)n * D + kc) = w; } }
    { f32x2* tab = (f32x2*)(KWS() + WS_ROPE);
      for (int i = gt; i < SEQ * 32; i += NGT) { const int pos = i >> 5, k = i & 31;
          const double t = (double)pos * c_invfreq[k]; const double TWO_PI = 6.283185307179586476925286766559;
          const double kk = __builtin_rint(t * (1.0 / TWO_PI)); const double x = t - kk * TWO_PI; const double x2 = x * x;
          double sn = -1.0 / 51090942171709440000.0;
          sn = sn * x2 + 1.0 / 121645100408832000.0; sn = sn * x2 - 1.0 / 355687428096000.0; sn = sn * x2 + 1.0 / 1307674368000.0; sn = sn * x2 - 1.0 / 6227020800.0;
          sn = sn * x2 + 1.0 / 39916800.0; sn = sn * x2 - 1.0 / 362880.0; sn = sn * x2 + 1.0 / 5040.0; sn = sn * x2 - 1.0 / 120.0; sn = sn * x2 + 1.0 / 6.0; sn = -sn * x2 + 1.0; sn = sn * x;
          double cs = 1.0 / 2432902008176640000.0;
          cs = cs * x2 - 1.0 / 6402373705728000.0; cs = cs * x2 + 1.0 / 20922789888000.0; cs = cs * x2 - 1.0 / 87178291200.0; cs = cs * x2 + 1.0 / 479001600.0;
          cs = cs * x2 - 1.0 / 3628800.0; cs = cs * x2 + 1.0 / 40320.0; cs = cs * x2 - 1.0 / 720.0; cs = cs * x2 + 1.0 / 24.0; cs = cs * x2 - 0.5; cs = cs * x2 + 1.0;
          tab[i] = (f32x2){(float)cs, (float)sn}; } }
}

__device__ __forceinline__ void mla_post_phase(const Ctx& C) {
    const float* down = (const float*)(KWS() + WS_BIG + BG_DOWN);
    bf16* cqn = (bf16*)(KWS() + WS_US + US_CQN); bf16* ckvn = (bf16*)(KWS() + WS_US + US_CKVN); bf16* kpeb = (bf16*)(KWS() + WS_US + US_KPEB);
    const float* qn = KIN(20); const float* kvn = KIN(22); const f32x2* rope = (const f32x2*)(KWS() + WS_ROPE);
    const int lane = C.lane;
    for (int m = C.gw; m < T; m += C.NGW) {
        const float* r = down + (size_t)m * 768;
        f32x2 a[3]; float s = 0.f;
#pragma unroll
        for (int j = 0; j < 3; ++j) { a[j] = *(const f32x2*)(r + 2 * lane + 128 * j); s += a[j].x * a[j].x + a[j].y * a[j].y; }
        const float rstd = 1.0f / sqrtf(wave_sum(s) * (1.f / 384.f) + EPS);
#pragma unroll
        for (int j = 0; j < 3; ++j) { const f32x2 g = *(const f32x2*)(qn + 2 * lane + 128 * j); *(unsigned*)(cqn + (size_t)m * 384 + 2 * lane + 128 * j) = pk2(a[j].x * rstd * g.x, a[j].y * rstd * g.y); }
        const f32x4 v = *(const f32x4*)(r + 384 + 4 * lane);
        const float s2 = (v.x * v.x + v.y * v.y) + (v.z * v.z + v.w * v.w);
        const float rstd2 = 1.0f / sqrtf(wave_sum(s2) * (1.f / 256.f) + EPS);
        const f32x4 o = v * rstd2 * *(const f32x4*)(kvn + 4 * lane);
        float* ockv = (m < TP) ? KOUT() + O_CKVP + (size_t)m * 256 : KOUT() + O_CKVS + (size_t)(m - TP) * 256;
        *(f32x4*)(ockv + 4 * lane) = o;
        const int kr = tok_keyrow(m);
        *(u32x2*)(ckvn + (size_t)kr * 256 + 4 * lane) = (u32x2){pk2(o.x, o.y), pk2(o.z, o.w)};
        const int pos = tok_pos(m);
        if (lane < 32) {
            const float x1 = r[640 + lane], x2 = r[672 + lane]; const f32x2 cs = rope[(size_t)pos * 32 + lane];
            const float o1 = x1 * cs.x - x2 * cs.y, o2 = x1 * cs.y + x2 * cs.x;
            float* okpe = (m < TP) ? KOUT() + O_KPEP + (size_t)m * 64 : KOUT() + O_KPES + (size_t)(m - TP) * 64;
            okpe[lane] = o1; okpe[32 + lane] = o2;
            kpeb[(size_t)kr * 64 + lane] = (bf16)f2bf(o1); kpeb[(size_t)kr * 64 + 32 + lane] = (bf16)f2bf(o2);
        }
    }
    const int gt = C.gw * 64 + C.lane, NGT = C.NGW * 64;
    const float* cckv = KIN(3); const float* ckpe = KIN(4);
    for (int i = gt; i < DB * PAST * 40; i += NGT) {
        const int row = i / 40, pc = i - row * 40; const int b = row >> 10, j = row & 1023; const size_t kr = (size_t)TP + b * KSEQS + j;
        const float* src; bf16* dst;
        if (pc < 32) { src = cckv + (size_t)row * 256 + pc * 8; dst = ckvn + kr * 256 + pc * 8; } else { src = ckpe + (size_t)row * 64 + (pc - 32) * 8; dst = kpeb + kr * 64 + (pc - 32) * 8; }
        const f32x4 v0 = *(const f32x4*)src, v1 = *(const f32x4*)(src + 4);
        *(u32x4*)dst = (u32x4){pk2(v0.x, v0.y), pk2(v0.z, v0.w), pk2(v1.x, v1.y), pk2(v1.z, v1.w)};
    }
}

struct GlaSlot { int row0, h, b, hh; bool sample; };
__device__ __forceinline__ GlaSlot gla_slot(int slot, int hf) {
    GlaSlot s;
    if (slot < 1024) { const int sh = slot >> 7, c = slot & 127; s.b = sh >> 1; s.hh = sh & 1; s.row0 = s.b * SEQ + 64 * c; s.sample = false; }
    else { const int q = slot - 1024; s.b = q >> 1; s.hh = q & 1; s.row0 = TP + s.b * DSEQ; s.sample = true; }
    s.h = 2 * hf + s.hh; return s;
}
constexpr int KT_STR = 320, VT_STR = 576, QD_STR = 272, PP_STR = 144, OF_STR = 1040;
__device__ __forceinline__ void gla_pass_a(const Ctx& C, int hf) {
    const bf16* PROJ = (const bf16*)(KWS() + WS_BIG + BG_PROJ); const _Float16* LA = (const _Float16*)(KWS() + WS_BIG + BG_LA);
    bf16* US = (bf16*)(KWS() + WS_US); float* DEC = (float*)(KWS() + WS_DEC);
    LAS unsigned char* KT = C.lds; LAS unsigned char* VT = C.lds + 20480; LAS float* SEG = (LAS float*)(C.lds + 57344);
    const int tid = C.tid, lane = C.lane, w = C.wave, col = tid & 127, seg = tid >> 7;
    const int h2 = lane >> 5, cb = (lane >> 4) & 1, qq = (lane & 15) >> 2, p4 = lane & 3, r32 = lane & 31;
    for (int slot = blockIdx.x; slot < NSLOT; slot += C.G) {
        const GlaSlot S = gla_slot(slot, hf);
        const _Float16* la = LA + (size_t)(S.row0 + 16 * seg) * 512 + S.h * 128 + col;
        const bf16* kp = PROJ + (size_t)(S.row0 + 16 * seg) * GLA_NPROJ + 512 + S.h * 128 + col;
        float cs[16], kv[16]; float run = 0.f;
#pragma unroll
        for (int i = 0; i < 16; ++i) { run += (float)la[(size_t)i * 512]; cs[i] = run; kv[i] = bf2f(kp[(size_t)i * GLA_NPROJ]); }
        SEG[seg * 128 + col] = run;
#pragma unroll
        for (int i = 0; i < 4; ++i) { const int p = tid + 512 * i, r = p >> 5, ch = p & 31;
            const u32x4 v = *(const u32x4*)(PROJ + (size_t)(S.row0 + r) * GLA_NPROJ + 1024 + S.h * 256 + ch * 8);
            *(LAS u32x4*)(VT + r * VT_STR + ch * 16) = v; }
        __syncthreads();
        float pre = 0.f, tot = 0.f;
#pragma unroll
        for (int s = 0; s < 4; ++s) { const float x = SEG[s * 128 + col]; tot += x; if (s < seg) pre += x; }
#pragma unroll
        for (int i = 0; i < 16; ++i) { const float bb = pre + cs[i]; *(LAS bf16*)(KT + (16 * seg + i) * KT_STR + col * 2) = (bf16)f2bf(kv[i] * fast_exp(tot - bb)); }
        if (seg == 0) DEC[(size_t)slot * 128 + col] = fast_exp(tot);
        __syncthreads();
        const int dkt = w & 3, dvg = w >> 2;
        f32x16 acc[4];
#pragma unroll
        for (int j = 0; j < 4; ++j) acc[j] = (f32x16){};
#pragma unroll
        for (int ks = 0; ks < 4; ++ks) {
            const int krow = 16 * ks + 8 * h2 + qq;
            LAS const unsigned char* bp = KT + krow * KT_STR + (32 * dkt + 16 * cb + 4 * p4) * 2;
            const bf16x8 bfr = cat8(ds_tr((LAS const char*)bp), ds_tr((LAS const char*)(bp + 4 * KT_STR)));
#pragma unroll
            for (int j = 0; j < 4; ++j) {
                LAS const unsigned char* ap = VT + krow * VT_STR + (32 * (dvg * 4 + j) + 16 * cb + 4 * p4) * 2;
                const bf16x8 afr = cat8(ds_tr((LAS const char*)ap), ds_tr((LAS const char*)(ap + 4 * VT_STR)));
                acc[j] = MFMA32(afr, bfr, acc[j]);
            }
        }
        bf16* us = US + (size_t)slot * 32768 + (size_t)(32 * dkt + r32) * 256;
#pragma unroll
        for (int j = 0; j < 4; ++j)
#pragma unroll
            for (int g = 0; g < 4; ++g) {
                const int dv = 32 * (dvg * 4 + j) + 8 * g + 4 * h2;
                *(u32x2*)(us + dv) = (u32x2){pk2(acc[j][4 * g], acc[j][4 * g + 1]), pk2(acc[j][4 * g + 2], acc[j][4 * g + 3])};
            }
        __syncthreads();
    }
}
__device__ __forceinline__ void gla_pass_b(const Ctx& C, int hf) {
    bf16* US = (bf16*)(KWS() + WS_US); const float* DEC = (const float*)(KWS() + WS_DEC);
    const int gwv = C.wave * C.G + blockIdx.x;
    const int nwv = NWAVES * C.G;
    const int npw = 512;
    if (gwv < npw) {
        const int gid = gwv * 64 + C.lane; const int sh = gid >> 12, e = gid & 4095, dk = e >> 5;
        const int b = sh >> 1, h = 2 * hf + (sh & 1);
        float S[8];
#pragma unroll
        for (int j = 0; j < 8; ++j) S[j] = 0.f;
        u32x4* up = (u32x4*)(US + (size_t)(sh * 128) * 32768) + e;
        const float* dp = DEC + (size_t)(sh * 128) * 128 + dk;
        u32x4 ua[8], ub[8]; float da[8], db[8];
#define PB_LOAD(U, Dd, c0) do { _Pragma("unroll") for (int k = 0; k < 8; ++k) { U[k] = up[(size_t)((c0) + k) * 4096]; Dd[k] = dp[((c0) + k) * 128]; } } while (0)
#define PB_STEP(U, Dd, c0) do { _Pragma("unroll") for (int k = 0; k < 8; ++k) { const u32x4 u = U[k]; const float d = Dd[k]; \
            u32x4 o; o.x = pk2(S[0], S[1]); o.y = pk2(S[2], S[3]); o.z = pk2(S[4], S[5]); o.w = pk2(S[6], S[7]); up[(size_t)((c0) + k) * 4096] = o; \
            S[0] = d * S[0] + __uint_as_float(u.x << 16); S[1] = d * S[1] + __uint_as_float(u.x & 0xffff0000u); \
            S[2] = d * S[2] + __uint_as_float(u.y << 16); S[3] = d * S[3] + __uint_as_float(u.y & 0xffff0000u); \
            S[4] = d * S[4] + __uint_as_float(u.z << 16); S[5] = d * S[5] + __uint_as_float(u.z & 0xffff0000u); \
            S[6] = d * S[6] + __uint_as_float(u.w << 16); S[7] = d * S[7] + __uint_as_float(u.w & 0xffff0000u); } } while (0)
        PB_LOAD(ua, da, 0);
#pragma unroll 1
        for (int c0 = 0; c0 < 128; c0 += 16) {
            PB_LOAD(ub, db, c0 + 8);
            PB_STEP(ua, da, c0);
            if (c0 + 16 < 128) PB_LOAD(ua, da, c0 + 16);
            PB_STEP(ub, db, c0 + 8);
        }
#undef PB_LOAD
#undef PB_STEP
        float* o = KOUT() + O_GLAP + ((size_t)(b * 4 + h) * 32768) + (size_t)e * 8;
        *(f32x4*)o = (f32x4){S[0], S[1], S[2], S[3]}; *(f32x4*)(o + 4) = (f32x4){S[4], S[5], S[6], S[7]};
    } else {
        const int nsw = nwv - npw;
        for (int q = gwv - npw; q < 64 * 64; q += nsw) {
            const int gid = q * 64 + C.lane; const int ss = gid >> 12, e = gid & 4095, dk = e >> 5;
            const int b = ss >> 1, h = 2 * hf + (ss & 1); const int slot = 1024 + ss;
            const float* s0 = KIN(2) + ((size_t)(b * 4 + h) * 32768) + (size_t)e * 8;
            const f32x4 a0 = *(const f32x4*)s0, a1 = *(const f32x4*)(s0 + 4);
            u32x4* up = (u32x4*)(US + (size_t)slot * 32768) + e; const u32x4 u = *up; const float d = DEC[(size_t)slot * 128 + dk];
            *up = (u32x4){pk2(a0.x, a0.y), pk2(a0.z, a0.w), pk2(a1.x, a1.y), pk2(a1.z, a1.w)};
            float* o = KOUT() + O_GLAS + ((size_t)(b * 4 + h) * 32768) + (size_t)e * 8;
            *(f32x4*)o = (f32x4){d * a0.x + __uint_as_float(u.x << 16), d * a0.y + __uint_as_float(u.x & 0xffff0000u), d * a0.z + __uint_as_float(u.y << 16), d * a0.w + __uint_as_float(u.y & 0xffff0000u)};
            *(f32x4*)(o + 4) = (f32x4){d * a1.x + __uint_as_float(u.z << 16), d * a1.y + __uint_as_float(u.z & 0xffff0000u), d * a1.z + __uint_as_float(u.w << 16), d * a1.w + __uint_as_float(u.w & 0xffff0000u)};
        }
    }
    if (C.wave >= 2) late_weights(C, hf);
}
__device__ __forceinline__ void gla_pass_c(const Ctx& C, int hf) {
    const bf16* PROJ = (const bf16*)(KWS() + WS_BIG + BG_PROJ); const _Float16* LA = (const _Float16*)(KWS() + WS_BIG + BG_LA);
    const bf16* US = (const bf16*)(KWS() + WS_US); bf16* HB = (bf16*)(KWS() + WS_HB); const float* gnorm = KIN(17);
    LAS unsigned char* QD = C.lds; LAS unsigned char* KI = C.lds + 17408; LAS unsigned char* VT = C.lds + 34816; LAS unsigned char* PP = C.lds + 71680;
    LAS float* SEG = (LAS float*)(C.lds + 80896); LAS unsigned char* SS = C.lds + 82944; LAS unsigned char* OF = SS;
    const int tid = C.tid, lane = C.lane, w = C.wave, col = tid & 127, seg = tid >> 7;
    const int h2 = lane >> 5, cb = (lane >> 4) & 1, qq = (lane & 15) >> 2, p4 = lane & 3, r32 = lane & 31;
    for (int slot = blockIdx.x; slot < NSLOT; slot += C.G) {
        const GlaSlot S = gla_slot(slot, hf);
        const _Float16* la = LA + (size_t)(S.row0 + 16 * seg) * 512 + S.h * 128 + col;
        const bf16* qp = PROJ + (size_t)(S.row0 + 16 * seg) * GLA_NPROJ + S.h * 128 + col;
        float cs[16], kv[16], qv[16]; float run = 0.f;
#pragma unroll
        for (int i = 0; i < 16; ++i) { run += (float)la[(size_t)i * 512]; cs[i] = run; qv[i] = bf2f(qp[(size_t)i * GLA_NPROJ]); kv[i] = bf2f(qp[(size_t)i * GLA_NPROJ + 512]); }
        SEG[seg * 128 + col] = run;
#pragma unroll
        for (int i = 0; i < 4; ++i) { const int p = tid + 512 * i, r = p >> 5, ch = p & 31;
            const u32x4 v = *(const u32x4*)(PROJ + (size_t)(S.row0 + r) * GLA_NPROJ + 1024 + S.h * 256 + ch * 8);
            *(LAS u32x4*)(VT + r * VT_STR + ch * 16) = v; }
#pragma unroll
        for (int i = 0; i < 8; ++i) { const int p = tid + 512 * i, r = p >> 5, ch = p & 31;
            const u32x4 v = *(const u32x4*)(US + (size_t)slot * 32768 + r * 256 + ch * 8);
            *(LAS u32x4*)(SS + r * VT_STR + ch * 16) = v; }
        __syncthreads();
        float pre = 0.f;
#pragma unroll
        for (int s = 0; s < 4; ++s) { const float x = SEG[s * 128 + col]; if (s < seg) pre += x; }
#pragma unroll
        for (int i = 0; i < 16; ++i) { const float bb = pre + cs[i]; const int t = 16 * seg + i;
            *(LAS bf16*)(QD + t * QD_STR + col * 2) = (bf16)f2bf(qv[i] * 0.08838834764831845f * fast_exp(bb));
            *(LAS bf16*)(KI + t * QD_STR + col * 2) = (bf16)f2bf(kv[i] * fast_exp(-bb)); }
        __syncthreads();
        if (w < 4) {
            const int st = w >> 1, tt = (w == 0) ? 0 : (w == 3 ? 0 : 1);
            f32x16 sc = (f32x16){};
            if (w < 3) {
#pragma unroll
                for (int ks = 0; ks < 8; ++ks) {
                    const bf16x8 a = *(LAS const bf16x8*)(KI + (32 * st + r32) * QD_STR + (16 * ks + 8 * h2) * 2);
                    const bf16x8 b = *(LAS const bf16x8*)(QD + (32 * tt + r32) * QD_STR + (16 * ks + 8 * h2) * 2);
                    sc = MFMA32(a, b, sc);
                }
            }
            const int t = 32 * tt + r32;
#pragma unroll
            for (int g = 0; g < 4; ++g) { const int s0 = 32 * st + 8 * g + 4 * h2; float v[4];
#pragma unroll
                for (int e = 0; e < 4; ++e) v[e] = (s0 + e <= t) ? sc[4 * g + e] : 0.f;
                *(LAS u32x2*)(PP + t * PP_STR + s0 * 2) = (u32x2){pk2(v[0], v[1]), pk2(v[2], v[3])}; }
        }
        __syncthreads();
        f32x16 oc[2]; oc[0] = (f32x16){}; oc[1] = (f32x16){};
#pragma unroll
        for (int ks = 0; ks < 4; ++ks) {
            LAS const unsigned char* bp = VT + (16 * ks + 8 * h2 + qq) * VT_STR + (32 * w + 16 * cb + 4 * p4) * 2;
            const bf16x8 bfr = cat8(ds_tr((LAS const char*)bp), ds_tr((LAS const char*)(bp + 4 * VT_STR)));
#pragma unroll
            for (int tt = 0; tt < 2; ++tt) { const bf16x8 a = *(LAS const bf16x8*)(PP + (32 * tt + r32) * PP_STR + (16 * ks + 8 * h2) * 2); oc[tt] = MFMA32(a, bfr, oc[tt]); }
        }
#pragma unroll
        for (int ks = 0; ks < 8; ++ks) {
            LAS const unsigned char* bp = SS + (16 * ks + 8 * h2 + qq) * VT_STR + (32 * w + 16 * cb + 4 * p4) * 2;
            const bf16x8 bfr = cat8(ds_tr((LAS const char*)bp), ds_tr((LAS const char*)(bp + 4 * VT_STR)));
#pragma unroll
            for (int tt = 0; tt < 2; ++tt) { const bf16x8 a = *(LAS const bf16x8*)(QD + (32 * tt + r32) * QD_STR + (16 * ks + 8 * h2) * 2); oc[tt] = MFMA32(a, bfr, oc[tt]); }
        }
        __syncthreads();
#pragma unroll
        for (int tt = 0; tt < 2; ++tt)
#pragma unroll
            for (int r = 0; r < 16; ++r) { const int t = 32 * tt + (r & 3) + 8 * (r >> 2) + 4 * h2; *(LAS float*)(OF + t * OF_STR + (32 * w + r32) * 4) = oc[tt][r]; }
        __syncthreads();
        {
            const int t = tid >> 3, part = tid & 7; const int row = S.row0 + t;
            f32x4 v[8]; float ssq = 0.f;
#pragma unroll
            for (int j = 0; j < 8; ++j) { v[j] = *(LAS const f32x4*)(OF + t * OF_STR + (j * 32 + part * 4) * 4); ssq += (v[j].x * v[j].x + v[j].y * v[j].y) + (v[j].z * v[j].z + v[j].w * v[j].w); }
            ssq += __shfl_xor(ssq, 1); ssq += __shfl_xor(ssq, 2); ssq += __shfl_xor(ssq, 4);
            const float rstd = 1.0f / sqrtf(ssq * (1.f / 256.f) + EPS);
            const bf16* gp = PROJ + (size_t)row * GLA_NPROJ + 2048 + S.h * 256; bf16* op = HB + (size_t)row * D + S.h * 256;
#pragma unroll
            for (int j = 0; j < 8; ++j) { const int dv = j * 32 + part * 4; const u32x2 gg = *(const u32x2*)(gp + dv); const f32x4 gn = *(const f32x4*)(gnorm + dv);
                const float g0 = __uint_as_float(gg.x << 16), g1 = __uint_as_float(gg.x & 0xffff0000u), g2 = __uint_as_float(gg.y << 16), g3 = __uint_as_float(gg.y & 0xffff0000u);
                *(u32x2*)(op + dv) = (u32x2){pk2(v[j].x * rstd * gn.x * silu_f(g0), v[j].y * rstd * gn.y * silu_f(g1)), pk2(v[j].z * rstd * gn.z * silu_f(g2), v[j].w * rstd * gn.w * silu_f(g3))}; }
        }
        __syncthreads();
    }
}

constexpr int AK_STR = 400, AV_STR = 320, AKB = 64 * AK_STR, AVB = 64 * AV_STR;
__device__ __forceinline__ void attn_phase(const Ctx& C, int hf) {
    const bf16* Q = (const bf16*)(KWS() + WS_BIG + BG_Q); const bf16* KU = (const bf16*)(KWS() + WS_BIG + BG_KU); const bf16* VU = (const bf16*)(KWS() + WS_BIG + BG_VU);
    const bf16* KPEB = (const bf16*)(KWS() + WS_US + US_KPEB); bf16* O = (bf16*)(KWS() + WS_HB);
    unsigned* ctr = (unsigned*)(KWS() + WS_CTL) + 512 + 256 * hf;
    const int xcd = (int)((unsigned)__builtin_amdgcn_s_getreg((3 << 11) | 20) & 7u);
    LAS unsigned char* KB = C.lds; LAS unsigned char* VB = C.lds + 2 * AKB; LAS int* ITEM = (LAS int*)(C.lds + 2 * AKB + 2 * AVB);
    const int tid = C.tid, lane = C.lane, w = C.wave;
    const int h2 = lane >> 5, cb = (lane >> 4) & 1, qq = (lane & 15) >> 2, p4 = lane & 3, r32 = lane & 31;
    for (;;) {
        if (tid == 0) {
            int got = -1;
            for (int k = 0; k < 8; ++k) { const int q = (xcd + k) & 7; const unsigned idx = atomicAdd(ctr + 16 * q, 1u); if (idx < 80u) { got = q * 80 + (int)idx; break; } }
            ITEM[0] = got;
        }
        __syncthreads();
        const int item = ITEM[0];
        if (item < 0) break;
        int b, hl, keyrow0, qrow0, ntb, ntw;
        { const int q = item / 80, i = item - q * 80;
          if (i < 64) { const int qb = 31 - (i >> 1), combo = 2 * q + (i & 1); b = combo >> 2; hl = combo & 3; keyrow0 = b * SEQ; qrow0 = b * SEQ + 256 * qb; ntb = 4 * qb + 4; ntw = 4 * qb + (w >> 1) + 1; }
          else { const int j = q * 16 + (i - 64); b = j >> 2; hl = j & 3; keyrow0 = TP + b * KSEQS; qrow0 = TP + b * DSEQ; ntb = 17; ntw = (w < 2) ? 17 : 0; } }
        const int head = 4 * hf + hl;
        bf16x8 qf[12];
        if (ntw > 0) {
            const GAS bf16* qp = (const GAS bf16*)(Q + (size_t)(qrow0 + 32 * w + r32) * 1536 + head * 192 + 8 * h2);
#pragma unroll
            for (int ks = 0; ks < 12; ++ks) qf[ks] = *(const GAS bf16x8*)(qp + 16 * ks);
        } else {
#pragma unroll
            for (int ks = 0; ks < 12; ++ks) qf[ks] = (bf16x8){};
        }
        f32x16 o[4];
#pragma unroll
        for (int j = 0; j < 4; ++j) o[j] = (f32x16){};
        float mrun = 0.f, lrun = 0.f;
        const int kr_ = tid >> 4, kc_ = tid & 15, pr_ = tid >> 3, pc_ = tid & 7;
        const GAS bf16* ksrc = (const GAS bf16*)(KU + (size_t)(keyrow0 + kr_) * 512 + hl * 128 + kc_ * 8);
        const GAS bf16* vsrc = (const GAS bf16*)(VU + (size_t)(keyrow0 + kr_) * 512 + hl * 128 + kc_ * 8);
        const GAS bf16* psrc = (const GAS bf16*)(KPEB + (size_t)(keyrow0 + pr_) * 64 + pc_ * 8);
        u32x4 pre[5];
#define ATT_LOAD(t) do { const size_t o_ = (size_t)(t) * 64; pre[0] = *(const GAS u32x4*)(ksrc + o_ * 512); pre[1] = *(const GAS u32x4*)(ksrc + (o_ + 32) * 512); \
        pre[2] = *(const GAS u32x4*)(vsrc + o_ * 512); pre[3] = *(const GAS u32x4*)(vsrc + (o_ + 32) * 512); pre[4] = *(const GAS u32x4*)(psrc + o_ * 64); } while (0)
#define ATT_STORE(bufi) do { LAS unsigned char* kb_ = KB + (bufi) * AKB; LAS unsigned char* vb_ = VB + (bufi) * AVB; \
        *(LAS u32x4*)(kb_ + kr_ * AK_STR + kc_ * 16) = pre[0]; *(LAS u32x4*)(kb_ + (kr_ + 32) * AK_STR + kc_ * 16) = pre[1]; \
        *(LAS u32x4*)(vb_ + kr_ * AV_STR + kc_ * 16) = pre[2]; *(LAS u32x4*)(vb_ + (kr_ + 32) * AV_STR + kc_ * 16) = pre[3]; \
        *(LAS u32x4*)(kb_ + pr_ * AK_STR + 256 + pc_ * 16) = pre[4]; } while (0)
        ATT_LOAD(0); ATT_STORE(0);
        __syncthreads();
        if (ntw > 0) {
            LAS const unsigned char* kb = KB + r32 * AK_STR + 16 * h2;
            f32x16 sr = (f32x16){};
#pragma unroll
            for (int ks = 0; ks < 12; ++ks) { const bf16x8 a0 = *(LAS const bf16x8*)(kb + ks * 32); sr = MFMA32(a0, qf[ks], sr); }
            float m0 = sr[0];
#pragma unroll
            for (int r = 1; r < 16; ++r) m0 = fmaxf(m0, sr[r]);
            auto rr = __builtin_amdgcn_permlane32_swap(__float_as_uint(m0), __float_as_uint(m0), false, false);
            mrun = fmaxf(__uint_as_float(rr[0]), __uint_as_float(rr[1]));
        }
        for (int t = 0; t < ntb; ++t) {
            const int cur = t & 1;
            if (t + 1 < ntb) ATT_LOAD(t + 1);
            if (t < ntw) {
                LAS const unsigned char* kb = KB + cur * AKB + r32 * AK_STR + 16 * h2; LAS const unsigned char* vb = VB + cur * AVB;
                f32x16 s0, s1;
#pragma unroll
                for (int r = 0; r < 16; ++r) { s0[r] = -mrun; s1[r] = -mrun; }
                float mx0 = 0.f, mx1 = 0.f, ls = 0.f;
                bf16x8 pf[4];
#define ATT_KF(i) (*(LAS const bf16x8*)(kb + ((i) < 12 ? (i) * 32 : 32 * AK_STR + ((i) - 12) * 32)))
#define ATT_VF(i) cat8(ds_tr((LAS const char*)(vb + (16 * ((i) >> 2) + 4 * h2 + qq) * AV_STR + (32 * ((i) & 3) + 16 * cb + 4 * p4) * 2)), ds_tr((LAS const char*)(vb + (16 * ((i) >> 2) + 4 * h2 + qq + 8) * AV_STR + (32 * ((i) & 3) + 16 * cb + 4 * p4) * 2)))
                bf16x8 kq[3], vq[2];
                kq[0] = ATT_KF(0); kq[1] = ATT_KF(1); kq[2] = ATT_KF(2);
                __builtin_amdgcn_sched_barrier(0);
#pragma unroll
                for (int i = 0; i < 24; ++i) {
                    const bf16x8 ac = kq[i % 3];
                    if (i + 3 < 24) kq[i % 3] = ATT_KF(i + 3);
                    if (i == 22) vq[0] = ATT_VF(0);
                    if (i == 23) vq[1] = ATT_VF(1);
                    if (i < 12) s0 = MFMA32(ac, qf[i], s0); else s1 = MFMA32(ac, qf[i - 12], s1);
                    const int ks = i - 12;
                    if (ks == 0) mx0 = fmaxf(fmaxf(fmaxf(s0[0], s0[1]), fmaxf(s0[2], s0[3])), fmaxf(fmaxf(s0[4], s0[5]), fmaxf(s0[6], s0[7])));
                    if (ks == 1) mx0 = fmaxf(mx0, fmaxf(fmaxf(fmaxf(s0[8], s0[9]), fmaxf(s0[10], s0[11])), fmaxf(fmaxf(s0[12], s0[13]), fmaxf(s0[14], s0[15]))));
                    if (ks >= 2 && ks < 10) { const int r = 2 * (ks - 2); s0[r] = __builtin_amdgcn_exp2f(s0[r]); s0[r + 1] = __builtin_amdgcn_exp2f(s0[r + 1]); ls += s0[r] + s0[r + 1]; }
                    if (ks == 10) { const u32x4 x = (u32x4){pk2(s0[0], s0[1]), pk2(s0[2], s0[3]), pk2(s0[4], s0[5]), pk2(s0[6], s0[7])}; pf[0] = __builtin_bit_cast(bf16x8, x); }
                    if (ks == 11) { const u32x4 x = (u32x4){pk2(s0[8], s0[9]), pk2(s0[10], s0[11]), pk2(s0[12], s0[13]), pk2(s0[14], s0[15])}; pf[1] = __builtin_bit_cast(bf16x8, x); }
                    __builtin_amdgcn_sched_barrier(0);
                }
#pragma unroll
                for (int i = 0; i < 16; ++i) {
                    const int kk = i >> 2, j = i & 3;
                    const bf16x8 a = vq[i & 1];
                    if (i + 2 < 16) vq[i & 1] = ATT_VF(i + 2);
                    o[j] = MFMA32(a, pf[kk], o[j]);
                    if (i == 0) mx1 = fmaxf(fmaxf(fmaxf(s1[0], s1[1]), fmaxf(s1[2], s1[3])), fmaxf(fmaxf(s1[4], s1[5]), fmaxf(s1[6], s1[7])));
                    if (i == 1) mx1 = fmaxf(mx1, fmaxf(fmaxf(fmaxf(s1[8], s1[9]), fmaxf(s1[10], s1[11])), fmaxf(fmaxf(s1[12], s1[13]), fmaxf(s1[14], s1[15]))));
                    if (i >= 2 && i < 6) { const int r = 4 * (i - 2);
#pragma unroll
                        for (int e2 = 0; e2 < 4; ++e2) { s1[r + e2] = __builtin_amdgcn_exp2f(s1[r + e2]); ls += s1[r + e2]; } }
                    if (i == 6) { const u32x4 x = (u32x4){pk2(s1[0], s1[1]), pk2(s1[2], s1[3]), pk2(s1[4], s1[5]), pk2(s1[6], s1[7])}; pf[2] = __builtin_bit_cast(bf16x8, x); }
                    if (i == 7) { const u32x4 x = (u32x4){pk2(s1[8], s1[9]), pk2(s1[10], s1[11]), pk2(s1[12], s1[13]), pk2(s1[14], s1[15])}; pf[3] = __builtin_bit_cast(bf16x8, x); }
                    __builtin_amdgcn_sched_barrier(0);
                }
#undef ATT_KF
#undef ATT_VF
                lrun += ls;
                float mx = fmaxf(mx0, mx1);
                { auto rr = __builtin_amdgcn_permlane32_swap(__float_as_uint(mx), __float_as_uint(mx), false, false); mx = fmaxf(__uint_as_float(rr[0]), __uint_as_float(rr[1])); }
                if (__any(mx > 8.0f)) {
                    const float dl = fmaxf(mx, 0.f), alpha = __builtin_amdgcn_exp2f(-dl);
                    mrun += dl; lrun *= alpha;
#pragma unroll
                    for (int j = 0; j < 4; ++j) o[j] *= alpha;
                }
            }
            if (t + 1 < ntb) ATT_STORE(cur ^ 1);
            __syncthreads();
        }
#undef ATT_LOAD
#undef ATT_STORE
        if (ntw > 0) {
            const float l = lrun + __shfl_xor(lrun, 32); const float inv = 1.0f / l;
            GAS bf16* op = (GAS bf16*)(O + (size_t)(qrow0 + 32 * w + r32) * D + head * 128 + 4 * h2);
#pragma unroll
            for (int j = 0; j < 4; ++j)
#pragma unroll
                for (int g = 0; g < 4; ++g)
                    *(GAS u32x2*)(op + 32 * j + 8 * g) = (u32x2){pk2(o[j][4 * g] * inv, o[j][4 * g + 1] * inv), pk2(o[j][4 * g + 2] * inv, o[j][4 * g + 3] * inv)};
        }
    }
}

#define XB_TMO      128
#define XB_XCNT(j)  (256  + 64 * (j))
#define XB_XSUB(j)  (1280 + 64 * (j))
#define XB_XGEN(j)  (2304 + 64 * (j))
#define XB_TOP      3328
#define XB_TOPGEN   3392
#define XCD_BAR_WORDS 3456
#define XB_SPIN_CAP (1u << 18)

__device__ __forceinline__ unsigned xb_ld(unsigned* p)              { return __hip_atomic_load(p, __ATOMIC_RELAXED, __HIP_MEMORY_SCOPE_AGENT); }
__device__ __forceinline__ unsigned xb_add(unsigned* p, unsigned v) { return __hip_atomic_fetch_add(p, v, __ATOMIC_RELAXED, __HIP_MEMORY_SCOPE_AGENT); }
__device__ __forceinline__ unsigned xb_xcc_id() { return (unsigned)__builtin_amdgcn_s_getreg((3 << 11) | 20) & 0xFu; }
#define XB_SPIN(cond, bar) do { unsigned _sp = 0; while (cond) { __builtin_amdgcn_s_sleep(1); \
    if ((++_sp & 255u) == 0u) { if (xb_ld(&(bar)[XB_TMO])) break; if (_sp > XB_SPIN_CAP) { atomicAdd(&(bar)[XB_TMO], 1u); break; } } } } while (0)

struct XcdBarrier {
    unsigned* bar; unsigned x;
    volatile LAS unsigned* st;
};

__device__ __forceinline__ XcdBarrier xcd_barrier_post(unsigned* bar, volatile LAS unsigned* st) {
    XcdBarrier b; b.bar = bar; b.x = xb_xcc_id(); b.st = st;
    if (threadIdx.x == 0) (void)xb_add(&bar[XB_XCNT(b.x)], 1u);
    return b;
}
__device__ __forceinline__ void xcd_barrier_complete(unsigned* bar, unsigned x, unsigned& nloc, unsigned& nx) {
    const unsigned G = gridDim.x * gridDim.y * gridDim.z;
    unsigned sum, cnt, mine, sp = 0u;
    for (;;) {
        sum = 0u; cnt = 0u; mine = 0u;
#pragma unroll
        for (unsigned j = 0; j < 16; ++j) { const unsigned c = xb_ld(&bar[XB_XCNT(j)]); sum += c; cnt += (c > 0u) ? 1u : 0u; mine = (j == x) ? c : mine; }
        if (sum == G) break;
        __builtin_amdgcn_s_sleep(1);
        if ((++sp & 255u) == 0u) { if (xb_ld(&bar[XB_TMO])) break; if (sp > XB_SPIN_CAP) { atomicAdd(&bar[XB_TMO], 1u); break; } }
    }
    nloc = mine > 0u ? mine : 1u; nx = cnt > 0u ? cnt : 1u;
}

__device__ __forceinline__ void xcd_barrier(const XcdBarrier& b) {
    asm volatile("s_waitcnt vmcnt(0)" ::: "memory");
    __syncthreads();
    if (threadIdx.x == 0) {
        unsigned* bar = b.bar;
        __builtin_amdgcn_s_waitcnt(0);
        unsigned nloc = b.st[0], nx = b.st[1];
        if (nloc == 0u) { xcd_barrier_complete(bar, b.x, nloc, nx); b.st[0] = nloc; b.st[1] = nx; }
        const unsigned old = xb_add(&bar[XB_XSUB(b.x)], 1u);
        const unsigned gen = old / nloc;
        if (old + 1u == (gen + 1u) * nloc) {
            __builtin_amdgcn_fence(__ATOMIC_RELEASE, "agent");
            asm volatile("s_waitcnt vmcnt(0)" ::: "memory");
            const unsigned og = xb_add(&bar[XB_TOP], 1u);
            const unsigned tg = og / nx;
            if (og + 1u == (tg + 1u) * nx) xb_add(&bar[XB_TOPGEN], 1u);
            else XB_SPIN(xb_ld(&bar[XB_TOPGEN]) == tg, bar);
            __builtin_amdgcn_fence(__ATOMIC_ACQUIRE, "agent");
            xb_add(&bar[XB_XGEN(b.x)], 1u);
            asm volatile("s_waitcnt vmcnt(0)" ::: "memory");
        } else {
            XB_SPIN(xb_ld(&bar[XB_XGEN(b.x)]) == gen, bar);
            __builtin_amdgcn_fence(__ATOMIC_ACQUIRE, "agent");
            asm volatile("s_waitcnt vmcnt(0)" ::: "memory");
        }
    }
    __syncthreads();
}

using EpiResidFirst = EpiResid<true, true>;
struct Args { const float* in[27]; float* out; unsigned char* ws; int ph_lo, ph_hi; };
constexpr int NPHASE = 30;

__global__ void __launch_bounds__(NTHR, 2) mega_fwd(Args args) {
    extern __shared__ __attribute__((aligned(16))) unsigned char lds_raw[];
    Ctx C;
    C.lds = (LAS unsigned char*)lds_raw; C.tid = threadIdx.x; C.lane = C.tid & 63; C.wave = __builtin_amdgcn_readfirstlane(C.tid >> 6);
    C.G = gridDim.x; C.gw = blockIdx.x * NWAVES + C.wave; C.NGW = C.G * NWAVES;
#define ws KWS()
#define wsW (KWS() + WS_W)
#define X (KOUT() + O_Y)
#define HB ((bf16*)(KWS() + WS_HB))
    const int lo = args.ph_lo, hi = args.ph_hi;
    int ph = 0;
#if ONE_LAUNCH
    cg::grid_group grid = cg::this_grid();
    volatile LAS unsigned* bst = (volatile LAS unsigned*)(C.lds + LDS_BYTES - 64);
    if (C.tid < 2) bst[C.tid] = 0u;
    __syncthreads();
    XcdBarrier xbar = xcd_barrier_post((unsigned*)(KWS() + WS_BAR), bst);
#define SEAM() do { xcd_barrier(xbar); } while (0)
    if (lo > (1 << 28)) grid.sync();
#else
#define SEAM() do { } while (0)
#endif
#define PHASE_BEGIN if (ph >= lo && ph < hi) {
#define PHASE_END   if (ph + 1 < hi) SEAM(); } ++ph;

    PHASE_BEGIN prologue(C); PHASE_END
#define GEMM_PHASE_S(SCHED, EPI, A_, BT_, M_, N_, K_, ...) PHASE_BEGIN { pg8::Gemm g{(const bf16*)(A_), (const bf16*)(BT_), M_, N_, K_}; pg8::SCHED S; S.init(M_, N_, K_, C.G, (int)blockIdx.x); \
        EPI E{__VA_ARGS__}; pg8::gemm_phase<EPI, pg8::SCHED, true, true>(C.lds, g, S, E); } PHASE_END
#define GEMM_PHASE(...) GEMM_PHASE_S(StaticOrder, __VA_ARGS__)
#define R1 ((bf16*)(ws + WS_HB))
#define R2 ((bf16*)(ws + WS_US))
#define SSQ(i) ((float*)(ws + WS_SSQ) + (size_t)(i) * T)
#define PART_FFN ((float*)(ws + WS_US))
#define PART_MIX ((float*)(ws + WS_BIG))
#define FIXUP_PHASE(xb_, i_, P_, ps_) PHASE_BEGIN fixup_phase(C, X, xb_, SSQ(i_), P_, ps_, nullptr); PHASE_END
#define FFN_PHASES(f, xin, si, so, EPIR) \
    GEMM_PHASE(EpiSwiglu, xin, wsW + WO_FFN + (f) * FFN_B, T, 2 * FF, D, (bf16*)(ws + WS_BIG + BG_ACT), SSQ(si)) \
    GEMM_PHASE_S(SplitOrder, EPIR, ws + WS_BIG + BG_ACT, wsW + WO_FFN + (f) * FFN_B + W1T_B, T, D, FF, X, 0.5f, PART_FFN, R1, SSQ(so), KIN(0), KIN(1))
    FFN_PHASES(0, R1, 0, 1, EpiResidFirst)
    PHASE_BEGIN fixup_phase(C, X, R1, SSQ(1), PART_FFN, 0.5f, KIN(1)); PHASE_END
    GEMM_PHASE(EpiGlaIn, R1, wsW + WO_GLAIN, T, GLA_N, D, (bf16*)(ws + WS_BIG + BG_PROJ), (_Float16*)(ws + WS_BIG + BG_LA), KIN(16), SSQ(1))
    PHASE_BEGIN gla_pass_a(C, 0); PHASE_END
    PHASE_BEGIN gla_pass_b(C, 0); PHASE_END
    PHASE_BEGIN gla_pass_c(C, 0); PHASE_END
    PHASE_BEGIN gla_pass_a(C, 1); PHASE_END
    PHASE_BEGIN gla_pass_b(C, 1); PHASE_END
    PHASE_BEGIN gla_pass_c(C, 1); PHASE_END
    GEMM_PHASE_S(SplitOrder, EpiResid<true>, R1, wsW + WO_GLAOUT, T, D, D, X, 1.0f, PART_MIX, R2, SSQ(2), nullptr, nullptr)
    FIXUP_PHASE(R2, 2, PART_MIX, 1.0f)
    FFN_PHASES(1, R2, 2, 3, EpiResid<true>)
    FIXUP_PHASE(R1, 3, PART_FFN, 0.5f)
    FFN_PHASES(2, R1, 3, 4, EpiResid<true>)
    FIXUP_PHASE(R1, 4, PART_FFN, 0.5f)
    GEMM_PHASE(EpiF32, R1, wsW + WO_DOWN, T, 768, D, (float*)(ws + WS_BIG + BG_DOWN), 768, SSQ(4))
    PHASE_BEGIN mla_post_phase(C); PHASE_END
    PHASE_BEGIN
        { pg8::Gemm g{(const bf16*)(ws + WS_US + US_CQN), (const bf16*)(wsW + WO_UQ), T, 1024, 384}; pg8::StaticOrder S; S.init(T, 1024, 384, C.G, (int)blockIdx.x);
          EpiQ<false> E{(bf16*)(ws + WS_BIG + BG_Q), (const f32x2*)(ws + WS_ROPE)}; pg8::gemm_phase<EpiQ<false>, pg8::StaticOrder, true, true>(C.lds, g, S, E); }
        { pg8::Gemm g{(const bf16*)(ws + WS_US + US_CQN), (const bf16*)(wsW + WO_UQ + (size_t)1024 * 384 * 2), T, 512, 384}; pg8::StaticOrder S; S.init(T, 512, 384, C.G, (int)((blockIdx.x + 224u) % (unsigned)C.G));
          EpiQ<true> E{(bf16*)(ws + WS_BIG + BG_Q), (const f32x2*)(ws + WS_ROPE)}; pg8::gemm_phase<EpiQ<true>, pg8::StaticOrder, true, true>(C.lds, g, S, E); }
        { pg8::Gemm g{(const bf16*)(ws + WS_US + US_CKVN), (const bf16*)(wsW + WO_KVUP), TK, 1024, 256}; pg8::StaticOrder S; S.init(TK, 1024, 256, C.G, (int)((blockIdx.x + 128u) % (unsigned)C.G));
          EpiKV E{(bf16*)(ws + WS_BIG + BG_KU), (bf16*)(ws + WS_BIG + BG_VU)}; pg8::gemm_phase<EpiKV, pg8::StaticOrder, true, true>(C.lds, g, S, E); }
    PHASE_END
    PHASE_BEGIN attn_phase(C, 0); PHASE_END
    GEMM_PHASE(EpiKV, ws + WS_US + US_CKVN, wsW + WO_KVUP + (size_t)1024 * 256 * 2, TK, 1024, 256, (bf16*)(ws + WS_BIG + BG_KU), (bf16*)(ws + WS_BIG + BG_VU))
    PHASE_BEGIN attn_phase(C, 1); PHASE_END
    GEMM_PHASE_S(SplitOrder, EpiResid<true>, R1, wsW + WO_MLAOUT, T, D, D, X, 1.0f, PART_MIX, R2, SSQ(5), nullptr, nullptr)
    FIXUP_PHASE(R2, 5, PART_MIX, 1.0f)
    FFN_PHASES(3, R2, 5, 5, EpiResid<false>)
    PHASE_BEGIN final_norm_phase(C, X, KIN(26), (const float*)PART_FFN, 0.5f); PHASE_END
#undef ws
#undef wsW
#undef X
#undef HB
}

extern "C" void kernel_launch(void* const* d_in, const int* in_sizes, int n_in, void* d_out, int out_size, void* d_ws, size_t ws_size, hipStream_t stream) {
    static int grid = 0;
    if (grid == 0) {
        if (n_in != 27 || ws_size < WS_END) { fprintf(stderr, "kernel_launch: unexpected n_in %d / ws_size %zu\n", n_in, ws_size); grid = -1; return; }
        int dev = 0, cus = 0, per_cu = 0;
        hipGetDevice(&dev); hipDeviceGetAttribute(&cus, hipDeviceAttributeMultiprocessorCount, dev);
        if (hipFuncSetAttribute((const void*)mega_fwd, hipFuncAttributeMaxDynamicSharedMemorySize, LDS_BYTES) != hipSuccess) { fprintf(stderr, "kernel_launch: hipFuncSetAttribute failed\n"); grid = -1; return; }
        if (hipOccupancyMaxActiveBlocksPerMultiprocessor(&per_cu, (const void*)mega_fwd, NTHR, LDS_BYTES) != hipSuccess || per_cu < 1) { fprintf(stderr, "kernel_launch: occupancy query gave %d\n", per_cu); per_cu = 1; }
        (void)hipGetLastError();
        grid = cus * 1;
    }
    if (grid < 0) return;
    Args a{};
    for (int i = 0; i < 27; ++i) a.in[i] = (const float*)d_in[i];
    a.out = (float*)d_out; a.ws = (unsigned char*)d_ws;
#if ONE_LAUNCH
    a.ph_lo = 0; a.ph_hi = NPHASE;
    if (hipMemsetAsync((char*)d_ws + WS_BAR, 0, XCD_BAR_WORDS * 4, stream) != hipSuccess) { fprintf(stderr, "kernel_launch: memset failed\n"); return; }
    void* kargs[] = {&a};
    hipError_t e = hipLaunchCooperativeKernel((const void*)mega_fwd, dim3(grid), dim3(NTHR), kargs, LDS_BYTES, stream);
    if (e != hipSuccess) fprintf(stderr, "cooperative launch failed: %s (grid %d)\n", hipGetErrorString(e), grid);
#else
    for (int p = 0; p < NPHASE; ++p) { a.ph_lo = p; a.ph_hi = p + 1; hipLaunchKernelGGL(mega_fwd, dim3(grid), dim3(NTHR), LDS_BYTES, stream, a); }
#endif
}
```

```cpp
#include <hip/hip_runtime.h>
#include <hip/hip_cooperative_groups.h>
#include <cstdio>
#include <cstdint>
namespace cg = cooperative_groups;

#ifndef ONE_LAUNCH
#define ONE_LAUNCH 1
#endif

namespace pg8 {
#define PG8_LAS __attribute__((address_space(3)))
typedef unsigned short bf16_t;
typedef short bf16x8 __attribute__((ext_vector_type(8)));
typedef float f32x4 __attribute__((ext_vector_type(4)));
typedef unsigned u32x4 __attribute__((ext_vector_type(4)));
constexpr int BM = 256, BK = 64, HALF = 128, HTB = HALF * BK * 2  , STAGE_BYTES = 8 * HTB, NXCD = 8, WGM = 8;

__host__ __device__ __forceinline__ int lds_byte(int r, int c) { const int st = (r >> 4) * 2 + (c >> 5), rr = r & 15, cc = c & 31, ob = rr * 64 + cc * 2; return st * 1024 + (ob ^ (((ob >> 9) & 1) << 5)); }
__host__ __device__ __forceinline__ void stage_rc(int b, int& R, int& C) { const int st = b / 1024, sb = b % 1024, swz = sb ^ (((sb >> 9) & 1) << 5); R = (st >> 1) * 16 + swz / 64; C = (st & 1) * 32 + (swz % 64) / 2; }
__host__ __device__ __forceinline__ int perm32(int rho) { const int n = rho >> 4, i = rho & 15; return 8 * (i >> 2) + 4 * n + (i & 3); }

struct Unit { int pm, pn, k0, nt, part; };
struct Gemm { const bf16_t* A; const bf16_t* Bt; int M, N, K; };

struct StaticOrder {
    int nM, nN, nwg, G, c;
    int ntK;
    __host__ __device__ void init(int M, int N, int K, int G_, int c_) { nM = M / BM; nN = N / BM; nwg = nM * nN; G = G_; c = c_; ntK = K / BK; }
    __host__ __device__ bool next(int i, Unit& u) const {
        const long L = (long)i * G + c; if (L >= nwg) return false;
        int wgid = (int)L; { const int q = nwg / NXCD, r = nwg % NXCD, xcd = wgid % NXCD, off = wgid / NXCD; wgid = (xcd < r ? xcd * (q + 1) : r * (q + 1) + (xcd - r) * q) + off; }
        const int nig = WGM * nN, gid = wgid / nig, fm = gid * WGM, gsz = (nM - fm) < WGM ? (nM - fm) : WGM;
        u.pm = fm + ((wgid % nig) % gsz); u.pn = (wgid % nig) / gsz; u.k0 = 0; u.nt = ntK; u.part = -1; return true;
    }
    __device__ __forceinline__ void a_ready(const Unit&) const {}
    __device__ __forceinline__ void done(const Unit&) const {}
};

struct SplitOrder {
    StaticOrder full; int G, c, ntK; bool split;
    __host__ __device__ void init(int M, int N, int K, int G_, int c_) { G = G_; c = c_; ntK = K / BK; split = (G_ == 256 && N == 1024 && M == 34816); full.init(split ? 32768 : M, N, K, G_, c_); }
    __host__ __device__ bool next(int i, Unit& u) const {
        if (!split) return full.next(i, u);
        if (i < 2) return full.next(i, u);
        if (i > 2) return false;
        const int ru = c >> 3, part = c & 7, np = ntK >> 1; const int p0 = part * np / 8, p1 = (part + 1) * np / 8;
        u.pm = 128 + (ru >> 2); u.pn = ru & 3; u.k0 = 2 * p0; u.nt = 2 * (p1 - p0); u.part = part; return true;
    }
    __device__ __forceinline__ void a_ready(const Unit&) const {}
    __device__ __forceinline__ void done(const Unit&) const {}
};

__device__ __forceinline__ unsigned cvt_pk_bf16(float lo, float hi) { unsigned r; asm volatile("v_cvt_pk_bf16_f32 %0, %1, %2" : "=v"(r) : "v"(lo), "v"(hi)); return r; }
typedef float f32x2 __attribute__((ext_vector_type(2)));
template <class Epi, class Sched, bool ALIGN_EPI = false, bool SP2 = false>
__device__ __forceinline__ void gemm_phase(PG8_LAS unsigned char* lds, const Gemm g, const Sched& S, const Epi& E) {
    const int tid = threadIdx.x, wid = __builtin_amdgcn_readfirstlane(tid >> 6), lane = tid & 63, wr = wid >> 2, wc = wid & 3, fr = lane & 15, fq = lane >> 4;
    const int K = g.K;
    unsigned voffA[2], voffB[2];
#pragma unroll
    for (int i = 0; i < 2; ++i) { int R, C; stage_rc(tid * 16 + i * 8192, R, C); const int Rb = Epi::PERM ? ((R & ~31) + perm32(R & 31)) : R;
        voffA[i] = (unsigned)(R * K + C) * 2u; voffB[i] = (unsigned)(Rb * K + C) * 2u; }
    const size_t kstep = (size_t)(BK * 2);
    const size_t hstep = (size_t)HALF * K * 2;
    const size_t tstep = 2 * hstep;
    const unsigned ldsw = (unsigned)wid * 1024u;
    const int aoff = lds_byte(wr * 64 + fr, fq * 8), boff = lds_byte(wc * 32 + fr, fq * 8);
#define PG8_SA(b, h) (((b) * 2 + (h)) * HTB)
#define PG8_SB(b, h) ((4 + (b) * 2 + (h)) * HTB)
#define PG8_STAGE(bufoff, gbase, voff) do { _Pragma("unroll") for (int _i = 0; _i < 2; ++_i) \
        __builtin_amdgcn_global_load_lds((const unsigned*)((const char*)(gbase) + (voff)[_i]), (PG8_LAS unsigned*)(lds + (bufoff) + ldsw + _i * 8192), 16, 0, 0); } while (0)
#define PG8_LDA(dst, b, h) do { _Pragma("unroll") for (int m = 0; m < 4; ++m) _Pragma("unroll") for (int k = 0; k < 2; ++k) dst[m][k] = *(const PG8_LAS bf16x8*)(lds + PG8_SA(b, h) + aoff + m * 2048 + k * 1024); } while (0)
#define PG8_LDB(dst, b, h) do { _Pragma("unroll") for (int n = 0; n < 2; ++n) _Pragma("unroll") for (int k = 0; k < 2; ++k) dst[n][k] = *(const PG8_LAS bf16x8*)(lds + PG8_SB(b, h) + boff + n * 2048 + k * 1024); } while (0)
#define PG8_MMA(ai, bj, At, Bt) do { __builtin_amdgcn_s_setprio(1); _Pragma("unroll") for (int m = 0; m < 4; ++m) _Pragma("unroll") for (int n = 0; n < 2; ++n) _Pragma("unroll") for (int k = 0; k < 2; ++k) \
        acc[ai][bj][m][n] = __builtin_amdgcn_mfma_f32_16x16x32_bf16(Bt[n][k], At[m][k], acc[ai][bj][m][n], 0, 0, 0); __builtin_amdgcn_s_setprio(0); } while (0)
#define PG8_WAIT_V(n) asm volatile("s_waitcnt vmcnt(" #n ")" ::: "memory")
#define PG8_WAIT_L(n) asm volatile("s_waitcnt lgkmcnt(" #n ")" ::: "memory")
#define PG8_BAR __builtin_amdgcn_s_barrier()
#define PG8_SCHED __builtin_amdgcn_sched_barrier(0)
    Unit cur, nxt; int ui = 0;
    if (!S.next(0, cur)) return;
    float er[8];
#pragma unroll
    for (int i = 0; i < 8; ++i) er[i] = 0.f;
    f32x4 acc[2][2][4][2];
#pragma unroll
    for (int a = 0; a < 2; ++a)
#pragma unroll
        for (int b = 0; b < 2; ++b)
#pragma unroll
            for (int m = 0; m < 4; ++m)
#pragma unroll
                for (int n = 0; n < 2; ++n) acc[a][b][m][n] = (f32x4){0.f, 0.f, 0.f, 0.f};
    bf16x8 At[4][2], B0[2][2], B1[2][2];
    const char* cA = (const char*)g.A + (size_t)cur.pm * tstep + (size_t)cur.k0 * kstep; const char* cB = (const char*)g.Bt + (size_t)cur.pn * tstep + (size_t)cur.k0 * kstep;
    S.a_ready(cur);
    if constexpr (SP2) {
        PG8_STAGE(PG8_SB(0, 0), cB, voffB); PG8_STAGE(PG8_SB(0, 1), cB + hstep, voffB); PG8_STAGE(PG8_SA(0, 0), cA, voffA); PG8_STAGE(PG8_SA(0, 1), cA + hstep, voffA);
        if (wr == 1) PG8_BAR;
        PG8_WAIT_V(2); PG8_BAR;
        PG8_STAGE(PG8_SB(1, 0), cB + kstep, voffB); PG8_STAGE(PG8_SA(1, 0), cA + kstep, voffA); PG8_STAGE(PG8_SB(1, 1), cB + hstep + kstep, voffB);
        PG8_WAIT_V(6); PG8_BAR;
    } else {
        PG8_STAGE(PG8_SB(0, 0), cB, voffB); PG8_STAGE(PG8_SA(0, 0), cA, voffA); PG8_STAGE(PG8_SB(0, 1), cB + hstep, voffB); PG8_STAGE(PG8_SA(0, 1), cA + hstep, voffA);
        if (wr == 1) PG8_BAR;
        PG8_WAIT_V(4); PG8_BAR;
        PG8_STAGE(PG8_SB(1, 0), cB + kstep, voffB); PG8_STAGE(PG8_SA(1, 0), cA + kstep, voffA); PG8_STAGE(PG8_SB(1, 1), cB + hstep + kstep, voffB);
        PG8_WAIT_V(6); PG8_BAR;
    }
    for (;;) {
        const bool has_next = S.next(ui + 1, nxt);
        const char* nA = has_next ? (const char*)g.A + (size_t)nxt.pm * tstep + (size_t)nxt.k0 * kstep : cA; const char* nB = has_next ? (const char*)g.Bt + (size_t)nxt.pn * tstep + (size_t)nxt.k0 * kstep : cB;
        const int nt = cur.nt;
_Pragma("nounroll")
        for (int t = 0; t < nt; t += 2) {
            const bool last = (t == nt - 2);
            if (last) E.preload(er, cur, wr, fr);
            const char* a1 = cA + (size_t)(t + 1) * kstep;
            const char* a2 = last ? nA : cA + (size_t)(t + 2) * kstep; const char* b2 = last ? nB : cB + (size_t)(t + 2) * kstep;
            const char* a3 = a2 + kstep; const char* b3 = b2 + kstep;
            if (last && has_next) S.a_ready(nxt);
            if constexpr (SP2) {
            PG8_LDB(B0, 0, 0); PG8_LDB(B1, 0, 1); PG8_SCHED; PG8_LDA(At, 0, 0); PG8_STAGE(PG8_SA(1, 1), a1 + hstep, voffA);
            PG8_WAIT_V(8); PG8_WAIT_L(0); PG8_BAR; PG8_MMA(0, 0, At, B0); PG8_MMA(0, 1, At, B1); PG8_BAR; PG8_SCHED;
            PG8_LDA(At, 0, 1); PG8_STAGE(PG8_SB(0, 0), b2, voffB); PG8_STAGE(PG8_SB(0, 1), b2 + hstep, voffB); PG8_STAGE(PG8_SA(0, 0), a2, voffA);
            PG8_WAIT_V(8); PG8_WAIT_L(0); PG8_BAR; PG8_MMA(1, 0, At, B0); PG8_MMA(1, 1, At, B1); PG8_BAR; PG8_SCHED;
            PG8_LDB(B0, 1, 0); PG8_LDB(B1, 1, 1); PG8_SCHED; PG8_LDA(At, 1, 0); PG8_STAGE(PG8_SA(0, 1), a2 + hstep, voffA);
            PG8_WAIT_V(8); PG8_WAIT_L(0); PG8_BAR; PG8_MMA(0, 0, At, B0); PG8_MMA(0, 1, At, B1); PG8_BAR; PG8_SCHED;
            PG8_LDA(At, 1, 1); PG8_STAGE(PG8_SB(1, 0), b3, voffB); PG8_STAGE(PG8_SB(1, 1), b3 + hstep, voffB); PG8_STAGE(PG8_SA(1, 0), a3, voffA);
            PG8_WAIT_V(8); PG8_WAIT_L(0); PG8_BAR; PG8_MMA(1, 0, At, B0); PG8_MMA(1, 1, At, B1); PG8_BAR; PG8_SCHED;
            } else {
            PG8_LDB(B0, 0, 0); PG8_SCHED; PG8_LDA(At, 0, 0); PG8_STAGE(PG8_SA(1, 1), a1 + hstep, voffA);
            PG8_WAIT_L(8); PG8_BAR; PG8_WAIT_L(0); PG8_MMA(0, 0, At, B0); PG8_BAR; PG8_SCHED;
            PG8_LDB(B1, 0, 1); PG8_STAGE(PG8_SB(0, 0), b2, voffB);
            PG8_BAR; PG8_WAIT_L(0); PG8_MMA(0, 1, At, B1); PG8_BAR;
            PG8_LDA(At, 0, 1); PG8_STAGE(PG8_SA(0, 0), a2, voffA);
            PG8_BAR; PG8_WAIT_L(0); PG8_MMA(1, 0, At, B0); PG8_BAR; PG8_SCHED;
            PG8_STAGE(PG8_SB(0, 1), b2 + hstep, voffB);
            PG8_WAIT_V(6); PG8_BAR; PG8_MMA(1, 1, At, B1); PG8_BAR;
            PG8_LDB(B0, 1, 0); PG8_SCHED; PG8_LDA(At, 1, 0); PG8_STAGE(PG8_SA(0, 1), a2 + hstep, voffA);
            PG8_WAIT_L(8); PG8_BAR; PG8_WAIT_L(0); PG8_MMA(0, 0, At, B0); PG8_BAR; PG8_SCHED;
            PG8_LDB(B1, 1, 1); PG8_STAGE(PG8_SB(1, 0), b3, voffB);
            PG8_BAR; PG8_WAIT_L(0); PG8_MMA(0, 1, At, B1); PG8_BAR;
            PG8_LDA(At, 1, 1); PG8_STAGE(PG8_SA(1, 0), a3, voffA);
            PG8_BAR; PG8_WAIT_L(0); PG8_MMA(1, 0, At, B0); PG8_BAR; PG8_SCHED;
            PG8_STAGE(PG8_SB(1, 1), b3 + hstep, voffB);
            PG8_WAIT_V(6); PG8_BAR; PG8_MMA(1, 1, At, B1); PG8_BAR;
            }
        }
        if constexpr (ALIGN_EPI) { if (wr == 0) PG8_BAR; }
        if constexpr (!Epi::AFTER_DRAIN) { E(acc, cur, wr, wc, fr, fq, er); S.done(cur); }
        if (!has_next) break;
#pragma unroll
        for (int a = 0; a < 2; ++a)
#pragma unroll
            for (int b = 0; b < 2; ++b)
#pragma unroll
                for (int m = 0; m < 4; ++m)
#pragma unroll
                    for (int n = 0; n < 2; ++n) acc[a][b][m][n] = (f32x4){0.f, 0.f, 0.f, 0.f};
        cur = nxt; cA = nA; cB = nB; ++ui;
        if constexpr (ALIGN_EPI) { if (wr == 1) PG8_BAR; }
    }
    PG8_WAIT_V(0);
    if constexpr (!ALIGN_EPI) { if (wr == 0) PG8_BAR; }
    PG8_BAR;
    if constexpr (Epi::AFTER_DRAIN) { E.fused(acc, cur, wr, wc, fr, fq, lds, wid, lane); S.done(cur); }
#undef PG8_SA
#undef PG8_SB
#undef PG8_STAGE
#undef PG8_LDA
#undef PG8_LDB
#undef PG8_MMA
#undef PG8_WAIT_V
#undef PG8_WAIT_L
#undef PG8_BAR
#undef PG8_SCHED
}
}

#define GAS __attribute__((address_space(1)))
#define LAS __attribute__((address_space(3)))
typedef unsigned short bf16;
typedef float f32x4 __attribute__((ext_vector_type(4)));
typedef float f32x2 __attribute__((ext_vector_type(2)));
typedef float f32x16 __attribute__((ext_vector_type(16)));
typedef short bf16x8 __attribute__((ext_vector_type(8)));
typedef short s16x4 __attribute__((ext_vector_type(4)));
typedef unsigned u32x4 __attribute__((ext_vector_type(4)));
typedef unsigned u32x2 __attribute__((ext_vector_type(2)));

constexpr int NWAVES = 8, NTHR = 512;
constexpr int D = 1024, FF = 2816, TP = 32768, TS = 2048, T = TP + TS;
constexpr int SEQ = 8192, NB = 4, DB = 32, DSEQ = 64, PAST = 1024, KSEQS = PAST + DSEQ;
constexpr int TK = TP + DB * KSEQS;
constexpr float EPS = 1e-6f;
constexpr int GLA_NPROJ = 3072, GLA_N = 3584;
constexpr int NSLOT = 1088;
constexpr float QSCALE = 0.07216878364870322f * 1.4426950408889634f;

constexpr size_t O_Y = 0, O_GLAP = 35651584, O_CKVP = 36175872, O_KPEP = 44564480, O_GLAS = 46661632, O_CKVS = 50855936, O_KPES = 51380224;
constexpr size_t MiB = 1u << 20;
constexpr size_t WS_CTL = 0, WS_ROPE = 1 * MiB, WS_DEC = 3 * MiB, WS_W = 4 * MiB, WS_HB = 88 * MiB, WS_US = 156 * MiB, WS_BIG = 224 * MiB, WS_END = 462 * MiB;
constexpr size_t W1T_B = (size_t)2 * FF * D * 2, W2T_B = (size_t)D * FF * 2, FFN_B = W1T_B + W2T_B;
constexpr size_t WO_FFN = 0, WO_GLAIN = 4 * FFN_B, WO_GLAOUT = WO_GLAIN + (size_t)GLA_N * D * 2, WO_DOWN = WO_GLAOUT + (size_t)D * D * 2,
                 WO_UQ = WO_DOWN + (size_t)768 * D * 2, WO_KVUP = WO_UQ + (size_t)1536 * 384 * 2, WO_MLAOUT = WO_KVUP + (size_t)2 * 1024 * 256 * 2, WO_END = WO_MLAOUT + (size_t)D * D * 2;
static_assert(WO_END <= 84 * MiB, "weights");
constexpr size_t US_CQN = 0, US_CKVN = (size_t)T * 384 * 2, US_KPEB = US_CKVN + (size_t)TK * 256 * 2;
static_assert(US_KPEB + (size_t)TK * 64 * 2 <= 68 * MiB, "US");
constexpr size_t BG_ACT = 0, BG_PROJ = 0, BG_LA = (size_t)T * GLA_NPROJ * 2, BG_DOWN = 0, BG_Q = 0, BG_KU = (size_t)T * 1536 * 2, BG_VU = BG_KU + (size_t)TK * 512 * 2;
static_assert(BG_VU + (size_t)TK * 512 * 2 <= 238 * MiB && BG_LA + (size_t)T * 512 * 2 <= 238 * MiB, "BIG");
constexpr size_t WS_BAR = 16 * 1024;
constexpr size_t WS_SSQ = 128 * 1024;
static_assert(WS_SSQ + (size_t)6 * T * 4 <= MiB, "ssq");
constexpr int LDS_BYTES = 160 * 1024;

__device__ __forceinline__ unsigned f2bf(float f) { unsigned u = __builtin_bit_cast(unsigned, f); return (u + 0x7fffu + ((u >> 16) & 1u)) >> 16; }
__device__ __forceinline__ unsigned pk2(float lo, float hi) { return pg8::cvt_pk_bf16(lo, hi); }
__device__ __forceinline__ float bf2f(bf16 b) { return __uint_as_float(((unsigned)b) << 16); }
__device__ __forceinline__ float wave_sum(float v) {
#pragma unroll
    for (int o = 1; o < 64; o <<= 1) v += __shfl_xor(v, o);
    return v;
}
__device__ __forceinline__ float fast_exp(float x) { return __builtin_amdgcn_exp2f(x * 1.4426950408889634f); }
__device__ __forceinline__ float silu_f(float g) { return g * __builtin_amdgcn_rcpf(1.0f + fast_exp(-g)); }
__device__ __forceinline__ int tok_pos(int row) { return row < TP ? (row & (SEQ - 1)) : PAST + ((row - TP) & (DSEQ - 1)); }
__device__ __forceinline__ int tok_keyrow(int row) { if (row < TP) return row; const int s = row - TP; return TP + (s >> 6) * KSEQS + PAST + (s & 63); }

__device__ __forceinline__ float rstd_of(float ssq) { return 1.0f / sqrtf(ssq * (1.f / D) + EPS); }
using pg8::Unit; using pg8::BM; using pg8::HALF;
struct EpiSwiglu {
    static constexpr bool PERM = true, AFTER_DRAIN = false;
    bf16* O; const float* ssq;
    __device__ __forceinline__ void preload(float (&er)[8], const Unit& u, int wr, int fr) const {
        const int row0 = u.pm * BM + wr * 64 + fr;
#pragma unroll
        for (int ai = 0; ai < 2; ++ai)
#pragma unroll
            for (int m = 0; m < 4; ++m) er[ai * 4 + m] = ((const GAS float*)ssq)[row0 + ai * HALF + m * 16];
    }
    __device__ __forceinline__ void operator()(const f32x4 (&acc)[2][2][4][2], const Unit& u, int wr, int wc, int fr, int fq, const float (&er)[8]) const {
        const int row0 = u.pm * BM + wr * 64 + fr, col0 = u.pn * 128 + wc * 32 + 8 * fq;
#pragma unroll
        for (int ai = 0; ai < 2; ++ai)
#pragma unroll
            for (int m = 0; m < 4; ++m) {
                const int row = row0 + ai * HALF + m * 16; const float r = rstd_of(er[ai * 4 + m]);
                bf16* rowp = O + (size_t)row * FF + col0;
                const f32x4 g0 = acc[ai][0][m][0] * r, g1 = acc[ai][0][m][1] * r, u0 = acc[ai][1][m][0] * r, u1 = acc[ai][1][m][1] * r;
                u32x4 w;
                w.x = pk2(silu_f(g0[0]) * u0[0], silu_f(g0[1]) * u0[1]); w.y = pk2(silu_f(g0[2]) * u0[2], silu_f(g0[3]) * u0[3]);
                w.z = pk2(silu_f(g1[0]) * u1[0], silu_f(g1[1]) * u1[1]); w.w = pk2(silu_f(g1[2]) * u1[2], silu_f(g1[3]) * u1[3]);
                *(u32x4*)rowp = w;
            }
    }
};
template <bool WXB, bool FIRST = false> struct EpiResid {
    static constexpr bool PERM = false, AFTER_DRAIN = false;
    float* X; float scale; float* P; bf16* XB; float* SSQ; const float* Xp; const float* Xs;
    __device__ __forceinline__ void preload(float (&)[8], const Unit&, int, int) const {}
    __device__ __forceinline__ void operator()(const f32x4 (&acc)[2][2][4][2], const Unit& u, int wr, int wc, int fr, int fq, const float (&er)[8]) const {
        const int row0 = u.pm * BM + wr * 64 + fr, col0 = u.pn * BM + wc * 32 + 4 * fq;
        if (u.part >= 0) {
#pragma unroll
            for (int ai = 0; ai < 2; ++ai)
#pragma unroll
                for (int m = 0; m < 4; ++m) {
                    float* rowp = P + ((size_t)u.part * TS + (size_t)(row0 + ai * HALF + m * 16 - TP)) * D + col0;
#pragma unroll
                    for (int bj = 0; bj < 2; ++bj)
#pragma unroll
                        for (int n = 0; n < 2; ++n) *(f32x4*)(rowp + bj * HALF + n * 16) = acc[ai][bj][m][n];
                }
            return;
        }
#pragma unroll
        for (int ai = 0; ai < 2; ++ai)
#pragma unroll
            for (int m = 0; m < 4; ++m) {
                const int row = row0 + ai * HALF + m * 16;
                float* rowp = X + (size_t)row * D + col0; float s = 0.f;
                const float* inp = FIRST ? ((row < TP ? Xp + (size_t)row * D : Xs + (size_t)(row - TP) * D) + col0) : rowp;
#pragma unroll
                for (int bj = 0; bj < 2; ++bj)
#pragma unroll
                    for (int n = 0; n < 2; ++n) { f32x4 v = *(const f32x4*)(inp + bj * HALF + n * 16); v += acc[ai][bj][m][n] * scale; *(f32x4*)(rowp + bj * HALF + n * 16) = v;
                        if constexpr (WXB) { s += (v.x * v.x + v.y * v.y) + (v.z * v.z + v.w * v.w); *(u32x2*)(XB + (size_t)row * D + col0 + bj * HALF + n * 16) = (u32x2){pk2(v.x, v.y), pk2(v.z, v.w)}; } }
                if constexpr (WXB) { s += __shfl_xor(s, 16); s += __shfl_xor(s, 32); if (fq == 0) atomicAdd(SSQ + row, s); }
            }
    }
};
struct EpiF32 {
    static constexpr bool PERM = false, AFTER_DRAIN = false;
    float* O; int ldc; const float* ssq;
    __device__ __forceinline__ void preload(float (&er)[8], const Unit& u, int wr, int fr) const {
        const int row0 = u.pm * BM + wr * 64 + fr;
#pragma unroll
        for (int ai = 0; ai < 2; ++ai)
#pragma unroll
            for (int m = 0; m < 4; ++m) er[ai * 4 + m] = ((const GAS float*)ssq)[row0 + ai * HALF + m * 16];
    }
    __device__ __forceinline__ void operator()(const f32x4 (&acc)[2][2][4][2], const Unit& u, int wr, int wc, int fr, int fq, const float (&er)[8]) const {
        const int row0 = u.pm * BM + wr * 64 + fr, col0 = u.pn * BM + wc * 32 + 4 * fq;
#pragma unroll
        for (int ai = 0; ai < 2; ++ai)
#pragma unroll
            for (int m = 0; m < 4; ++m) {
                const int row = row0 + ai * HALF + m * 16; const float r = rstd_of(er[ai * 4 + m]);
                float* rowp = O + (size_t)row * ldc + col0;
#pragma unroll
                for (int bj = 0; bj < 2; ++bj)
#pragma unroll
                    for (int n = 0; n < 2; ++n) *(f32x4*)(rowp + bj * HALF + n * 16) = acc[ai][bj][m][n] * r;
            }
    }
};
__device__ __forceinline__ float logsig16(float x) {
    const float ax = __builtin_fabsf(x);
    const float l = __builtin_amdgcn_logf(1.0f + fast_exp(-ax)) * 0.6931471805599453f;
    return (fminf(x, 0.f) - l) * 0.0625f;
}
struct EpiGlaIn {
    static constexpr bool PERM = true, AFTER_DRAIN = false;
    bf16* P; _Float16* LA; const float* bgk; const float* ssq;
    __device__ __forceinline__ void preload(float (&er)[8], const Unit& u, int wr, int fr) const {
        const int row0 = u.pm * BM + wr * 64 + fr;
#pragma unroll
        for (int ai = 0; ai < 2; ++ai)
#pragma unroll
            for (int m = 0; m < 4; ++m) er[ai * 4 + m] = ((const GAS float*)ssq)[row0 + ai * HALF + m * 16];
    }
    __device__ __forceinline__ void operator()(const f32x4 (&acc)[2][2][4][2], const Unit& u, int wr, int wc, int fr, int fq, const float (&er)[8]) const {
        const int row0 = u.pm * BM + wr * 64 + fr;
        if (u.pn < 12) {
            const int col0 = u.pn * BM + wc * 32 + 8 * fq;
#pragma unroll
            for (int ai = 0; ai < 2; ++ai)
#pragma unroll
                for (int m = 0; m < 4; ++m) {
                    const int row = row0 + ai * HALF + m * 16; const float r = rstd_of(er[ai * 4 + m]);
                    bf16* rowp = P + (size_t)row * GLA_NPROJ + col0;
#pragma unroll
                    for (int bj = 0; bj < 2; ++bj) { const f32x4 v0 = acc[ai][bj][m][0] * r, v1 = acc[ai][bj][m][1] * r; u32x4 w;
                        w.x = pk2(v0[0], v0[1]); w.y = pk2(v0[2], v0[3]); w.z = pk2(v1[0], v1[1]); w.w = pk2(v1[2], v1[3]); *(u32x4*)(rowp + bj * HALF) = w; }
                }
        } else {
            const int col0 = (u.pn - 12) * BM + wc * 32 + 8 * fq;
            f32x4 bv[2][2];
#pragma unroll
            for (int bj = 0; bj < 2; ++bj)
#pragma unroll
                for (int n = 0; n < 2; ++n) bv[bj][n] = *(const f32x4*)(bgk + col0 + bj * HALF + 4 * n);
#pragma unroll
            for (int ai = 0; ai < 2; ++ai)
#pragma unroll
                for (int m = 0; m < 4; ++m) {
                    const int row = row0 + ai * HALF + m * 16; const float r = rstd_of(er[ai * 4 + m]);
                    _Float16* rowp = LA + (size_t)row * 512 + col0;
#pragma unroll
                    for (int bj = 0; bj < 2; ++bj) {
                        const f32x4 v0 = acc[ai][bj][m][0] * r + bv[bj][0], v1 = acc[ai][bj][m][1] * r + bv[bj][1];
                        typedef _Float16 h8 __attribute__((ext_vector_type(8)));
                        h8 w; w[0] = (_Float16)logsig16(v0[0]); w[1] = (_Float16)logsig16(v0[1]); w[2] = (_Float16)logsig16(v0[2]); w[3] = (_Float16)logsig16(v0[3]);
                        w[4] = (_Float16)logsig16(v1[0]); w[5] = (_Float16)logsig16(v1[1]); w[6] = (_Float16)logsig16(v1[2]); w[7] = (_Float16)logsig16(v1[3]);
                        *(h8*)(rowp + bj * HALF) = w; }
                }
        }
    }
};
template <bool ROPE> struct EpiQ {
    static constexpr bool PERM = true, AFTER_DRAIN = false;
    bf16* Q; const f32x2* rope;
    __device__ __forceinline__ void preload(float (&)[8], const Unit&, int, int) const {}
    __device__ __forceinline__ void operator()(const f32x4 (&acc)[2][2][4][2], const Unit& u, int wr, int wc, int fr, int fq, const float (&er)[8]) const {
        const int row0 = u.pm * BM + wr * 64 + fr;
        if constexpr (!ROPE) {
#pragma unroll
            for (int ai = 0; ai < 2; ++ai)
#pragma unroll
                for (int m = 0; m < 4; ++m) {
                    bf16* rowp = Q + (size_t)(row0 + ai * HALF + m * 16) * 1536 + wc * 32 + 8 * fq;
#pragma unroll
                    for (int bj = 0; bj < 2; ++bj) { const f32x4 v0 = acc[ai][bj][m][0] * QSCALE, v1 = acc[ai][bj][m][1] * QSCALE; u32x4 w;
                        w.x = pk2(v0[0], v0[1]); w.y = pk2(v0[2], v0[3]); w.z = pk2(v1[0], v1[1]); w.w = pk2(v1[2], v1[3]); *(u32x4*)(rowp + (2 * u.pn + bj) * 192) = w; }
                }
        } else {
            const int head = u.pn * 4 + wc, i0 = 8 * fq;
#pragma unroll
            for (int ai = 0; ai < 2; ++ai)
#pragma unroll
                for (int m = 0; m < 4; ++m) {
                    const int row = row0 + ai * HALF + m * 16; const int pos = tok_pos(row);
                    const f32x2* rp = rope + (size_t)pos * 32 + i0;
                    bf16* qp = Q + (size_t)row * 1536 + head * 192 + 128 + i0;
#pragma unroll
                    for (int n = 0; n < 2; ++n) {
                        float o1[4], o2[4];
#pragma unroll
                        for (int e = 0; e < 4; ++e) { const f32x2 cs = rp[4 * n + e]; const float x1 = acc[ai][0][m][n][e], x2 = acc[ai][1][m][n][e];
                            o1[e] = (x1 * cs.x - x2 * cs.y) * QSCALE; o2[e] = (x1 * cs.y + x2 * cs.x) * QSCALE; }
                        *(u32x2*)(qp + 4 * n) = (u32x2){pk2(o1[0], o1[1]), pk2(o1[2], o1[3])};
                        *(u32x2*)(qp + 32 + 4 * n) = (u32x2){pk2(o2[0], o2[1]), pk2(o2[2], o2[3])};
                    }
                    asm volatile("" ::: "memory");
                }
        }
    }
};
struct EpiKV {
    static constexpr bool PERM = true, AFTER_DRAIN = false;
    bf16* KU; bf16* VU;
    __device__ __forceinline__ void preload(float (&)[8], const Unit&, int, int) const {}
    __device__ __forceinline__ void operator()(const f32x4 (&acc)[2][2][4][2], const Unit& u, int wr, int wc, int fr, int fq, const float (&er)[8]) const {
        const int row0 = u.pm * BM + wr * 64 + fr;
        bf16* base = (u.pn < 2) ? KU : VU; const int col0 = (u.pn & 1) * BM + wc * 32 + 8 * fq;
#pragma unroll
        for (int ai = 0; ai < 2; ++ai)
#pragma unroll
            for (int m = 0; m < 4; ++m) {
                bf16* rowp = base + (size_t)(row0 + ai * HALF + m * 16) * 512 + col0;
#pragma unroll
                for (int bj = 0; bj < 2; ++bj) { const f32x4 v0 = acc[ai][bj][m][0], v1 = acc[ai][bj][m][1]; u32x4 w;
                    w.x = pk2(v0[0], v0[1]); w.y = pk2(v0[2], v0[3]); w.z = pk2(v1[0], v1[1]); w.w = pk2(v1[2], v1[3]); *(u32x4*)(rowp + bj * HALF) = w; }
            }
    }
};

__device__ __forceinline__ s16x4 ds_tr(LAS const char* p) {
    typedef short v4i16_t __attribute__((ext_vector_type(4)));
    return __builtin_bit_cast(s16x4, __builtin_amdgcn_ds_read_tr16_b64_v4i16((LAS v4i16_t*)p));
}
__device__ __forceinline__ bf16x8 cat8(s16x4 a, s16x4 b) { return (bf16x8){a[0], a[1], a[2], a[3], b[0], b[1], b[2], b[3]}; }
#define MFMA32(a, b, c) __builtin_amdgcn_mfma_f32_32x32x16_bf16((a), (b), (c), 0, 0, 0)

struct Ctx {
    LAS unsigned char* lds; int tid, lane, wave, G, gw, NGW;
};
typedef const unsigned long long __attribute__((address_space(4)))* kargp_t;
__device__ __forceinline__ const float* KIN(int i) { return (const float*)((kargp_t)__builtin_amdgcn_kernarg_segment_ptr())[i]; }
__device__ __forceinline__ float* KOUT() { return (float*)((kargp_t)__builtin_amdgcn_kernarg_segment_ptr())[27]; }
__device__ __forceinline__ unsigned char* KWS() { return (unsigned char*)((kargp_t)__builtin_amdgcn_kernarg_segment_ptr())[28]; }

__device__ __forceinline__ void first_row(const Ctx& C, const float* xrow, bf16* orow, float* ssq) {
    const f32x4* xr = (const f32x4*)xrow + C.lane;
    f32x4 v[4]; float s = 0.f;
#pragma unroll
    for (int j = 0; j < 4; ++j) { v[j] = xr[64 * j]; s += (v[j].x * v[j].x + v[j].y * v[j].y) + (v[j].z * v[j].z + v[j].w * v[j].w); }
    s = wave_sum(s); if (C.lane == 0) *ssq = s;
    unsigned long long* o8 = (unsigned long long*)orow + C.lane;
#pragma unroll
    for (int j = 0; j < 4; ++j) o8[64 * j] = (unsigned long long)pk2(v[j].x, v[j].y) | ((unsigned long long)pk2(v[j].z, v[j].w) << 32);
}
__device__ __forceinline__ void add_partials(const Ctx& C, f32x4 (&v)[4], int m, const float* P, float pscale) {
#pragma unroll 2
    for (int p = 0; p < 8; ++p) { const f32x4* pr = (const f32x4*)(P + ((size_t)p * TS + (size_t)(m - TP)) * D) + C.lane;
#pragma unroll
        for (int j = 0; j < 4; ++j) v[j] += pr[64 * j] * pscale; }
}
__device__ __forceinline__ void fixup_phase(const Ctx& C, float* x, bf16* xb, float* ssq, const float* P, float pscale, const float* xs_in) {
    if (C.G != 256) return;
    for (int m = TP + C.gw; m < T; m += C.NGW) {
        f32x4* xr = (f32x4*)(x + (size_t)m * D) + C.lane; const f32x4* xi = xs_in ? (const f32x4*)(xs_in + (size_t)(m - TP) * D) + C.lane : xr;
        f32x4 v[4];
#pragma unroll
        for (int j = 0; j < 4; ++j) v[j] = xi[64 * j];
        add_partials(C, v, m, P, pscale);
        float s = 0.f;
#pragma unroll
        for (int j = 0; j < 4; ++j) { xr[64 * j] = v[j]; s += (v[j].x * v[j].x + v[j].y * v[j].y) + (v[j].z * v[j].z + v[j].w * v[j].w); }
        s = wave_sum(s); if (C.lane == 0) ssq[m] = s;
        unsigned long long* o8 = (unsigned long long*)(xb + (size_t)m * D) + C.lane;
#pragma unroll
        for (int j = 0; j < 4; ++j) o8[64 * j] = (unsigned long long)pk2(v[j].x, v[j].y) | ((unsigned long long)pk2(v[j].z, v[j].w) << 32);
    }
}
__device__ __forceinline__ void final_norm_phase(const Ctx& C, float* x, const float* g, const float* P, float pscale) {
    const bool split = (C.G == 256);
    for (int m = C.gw; m < T; m += C.NGW) {
        f32x4* xr = (f32x4*)(x + (size_t)m * D) + C.lane; const f32x4* gr = (const f32x4*)g + C.lane;
        f32x4 v[4]; float s = 0.f;
#pragma unroll
        for (int j = 0; j < 4; ++j) v[j] = xr[64 * j];
        if (split && m >= TP) add_partials(C, v, m, P, pscale);
#pragma unroll
        for (int j = 0; j < 4; ++j) s += (v[j].x * v[j].x + v[j].y * v[j].y) + (v[j].z * v[j].z + v[j].w * v[j].w);
        const float rstd = 1.0f / sqrtf(wave_sum(s) * (1.f / D) + EPS);
#pragma unroll
        for (int j = 0; j < 4; ++j) xr[64 * j] = v[j] * rstd * gr[64 * j];
    }
}

__device__ __forceinline__ void tr_item(const float* W, int ldw, int k0, bf16* WT, int Kd, int dst_row0, LAS float* scr, int lane, const float* gain) {
#pragma unroll 16
    for (int i = 0; i < 32; ++i) { const int kk = 2 * i + (lane >> 5); float v = W[(size_t)(k0 + kk) * ldw + (lane & 31)]; if (gain) v *= gain[k0 + kk]; scr[kk * 33 + (lane & 31)] = v; }
    asm volatile("s_waitcnt lgkmcnt(0)" ::: "memory");
    const int c = lane & 7;
#pragma unroll
    for (int j = 0; j < 4; ++j) { const int n = (lane >> 3) + 8 * j; const LAS float* s = scr + (8 * c) * 33 + n;
        u32x4 o; o.x = pk2(s[0 * 33], s[1 * 33]); o.y = pk2(s[2 * 33], s[3 * 33]); o.z = pk2(s[4 * 33], s[5 * 33]); o.w = pk2(s[6 * 33], s[7 * 33]);
        *(u32x4*)(WT + (size_t)(dst_row0 + n) * Kd + k0 + 8 * c) = o; }
    asm volatile("s_waitcnt lgkmcnt(0)" ::: "memory");
}
enum { MAP_ID = 0, MAP_GATE = 1, MAP_UP = 2, MAP_UQ = 3, MAP_UK = 4, MAP_UV = 5 };
__device__ __forceinline__ int map_row(int map, int n) {
    switch (map) {
        case MAP_GATE: return 256 * (n >> 7) + (n & 127);
        case MAP_UP:   return 256 * (n >> 7) + 128 + (n & 127);
        case MAP_UQ: { const int h = n / 192, d = n - h * 192;
            if (d < 128) return h * 128 + d;
            if (d < 160) return 1024 + (h >> 2) * 256 + (h & 3) * 32 + (d - 128);
            return 1024 + (h >> 2) * 256 + 128 + (h & 3) * 32 + (d - 160); }
        case MAP_UK: { const int h = n >> 7, d = n & 127; return (h >> 2) * 1024 + (h & 3) * 128 + d; }
        case MAP_UV: { const int h = n >> 7, d = n & 127; return (h >> 2) * 1024 + 512 + (h & 3) * 128 + d; }
        default: return n;
    }
}
__device__ __forceinline__ bool tr_job(int& it, const float* W, int ldw, int K, int ncols, bf16* WT, int Kd, int map, LAS float* scr, int lane, const float* gain = nullptr) {
    const int nblk = ncols >> 5, items = (K >> 6) * nblk;
    if (it >= items) { it -= items; return false; }
    const int kb = it / nblk, nb = it - kb * nblk;
    tr_item(W + nb * 32, ldw, kb * 64, WT, Kd, map_row(map, nb * 32), scr, lane, gain);
    return true;
}

__constant__ double c_invfreq[32] = {1.0, 0.7498942093324559, 0.5623413251903491, 0.4216965034285822, 0.31622776601683794, 0.23713737056616552, 0.1778279410038923, 0.1333521432163324, 0.1,
    0.07498942093324558, 0.05623413251903491, 0.042169650342858224, 0.03162277660168379, 0.023713737056616554, 0.01778279410038923, 0.01333521432163324, 0.01, 0.007498942093324558,
    0.005623413251903491, 0.004216965034285823, 0.0031622776601683794, 0.0023713737056616554, 0.0017782794100389228, 0.001333521432163324, 0.001, 0.0007498942093324559, 0.0005623413251903491,
    0.00042169650342858224, 0.00031622776601683794, 0.00023713737056616554, 0.00017782794100389227, 0.0001333521432163324};

constexpr int I_W1 = (D / 64) * (FF / 32), I_W2 = (FF / 64) * (D / 32), I_FFN = 2 * I_W1 + I_W2;
constexpr int I_GLAIN = (D / 64) * (GLA_NPROJ / 32), I_SQ = (D / 64) * (D / 32), I_DOWN = (D / 64) * (704 / 32), I_UQ = (384 / 64) * (1536 / 32), I_UKV = (256 / 64) * (1024 / 32);
constexpr int N_EARLY = I_FFN + I_GLAIN, NITEMS = 4 * I_FFN + I_GLAIN + I_SQ + I_DOWN + I_UQ + 2 * I_UKV + I_SQ;
__device__ __forceinline__ void tr_dispatch(int it, LAS float* scr, int lane) {
    unsigned char* wsW = KWS() + WS_W;
    bool done = false;
    { const float* gn = KIN(5);
      done = tr_job(it, KIN(6), FF, D, FF, (bf16*)(wsW + WO_FFN), D, MAP_GATE, scr, lane, gn);
      if (!done) done = tr_job(it, KIN(7), FF, D, FF, (bf16*)(wsW + WO_FFN), D, MAP_UP, scr, lane, gn);
      if (!done) done = tr_job(it, KIN(8), D, FF, D, (bf16*)(wsW + WO_FFN + W1T_B), FF, MAP_ID, scr, lane); }
    if (!done) done = tr_job(it, KIN(14), 3088, D, GLA_NPROJ, (bf16*)(wsW + WO_GLAIN), D, MAP_ID, scr, lane, KIN(9));
    if (!done) done = tr_job(it, KIN(18), D, D, D, (bf16*)(wsW + WO_GLAOUT), D, MAP_ID, scr, lane);
#pragma unroll 1
    for (int f = 1; f < 4 && !done; ++f) {
        const int layer = f >> 1, second = f & 1;
        const float* wg = (second ? KIN(11) : KIN(6)) + (size_t)layer * D * FF; const float* wu = (second ? KIN(12) : KIN(7)) + (size_t)layer * D * FF; const float* wd = (second ? KIN(13) : KIN(8)) + (size_t)layer * FF * D;
        bf16* w1t = (bf16*)(wsW + WO_FFN + f * FFN_B); bf16* w2t = (bf16*)(wsW + WO_FFN + f * FFN_B + W1T_B);
        const float* gn = (second ? KIN(10) : KIN(5)) + (size_t)layer * D;
        done = tr_job(it, wg, FF, D, FF, w1t, D, MAP_GATE, scr, lane, gn);
        if (!done) done = tr_job(it, wu, FF, D, FF, w1t, D, MAP_UP, scr, lane, gn);
        if (!done) done = tr_job(it, wd, D, FF, D, w2t, FF, MAP_ID, scr, lane);
    }
    if (!done) done = tr_job(it, KIN(19), 704, D, 704, (bf16*)(wsW + WO_DOWN), D, MAP_ID, scr, lane, KIN(9) + D);
    if (!done) done = tr_job(it, KIN(21), 1536, 384, 1536, (bf16*)(wsW + WO_UQ), 384, MAP_UQ, scr, lane);
    if (!done) done = tr_job(it, KIN(23), 1024, 256, 1024, (bf16*)(wsW + WO_KVUP), 256, MAP_UK, scr, lane);
    if (!done) done = tr_job(it, KIN(24), 1024, 256, 1024, (bf16*)(wsW + WO_KVUP), 256, MAP_UV, scr, lane);
    if (!done) done = tr_job(it, KIN(25), D, D, D, (bf16*)(wsW + WO_MLAOUT), D, MAP_ID, scr, lane);
}
__device__ __forceinline__ void late_weights(const Ctx& C, int hf) {
    constexpr int N_LATE = NITEMS - N_EARLY, HALF_LATE = (N_LATE + 1) / 2;
    const int lo = N_EARLY + hf * HALF_LATE, hi = (hf == 0) ? N_EARLY + HALF_LATE : NITEMS;
    LAS float* scr = (LAS float*)(C.lds + C.wave * 16384);
    const int widx = blockIdx.x * 6 + (C.wave - 2), nw = C.G * 6;
    for (int it = lo + widx; it < hi; it += nw) tr_dispatch(it, scr, C.lane);
}

__device__ __forceinline__ void prologue(const Ctx& C) {
    unsigned char* wsW = KWS() + WS_W;
    LAS float* scr = (LAS float*)(C.lds + C.wave * 16384);
    if (blockIdx.x == 0) for (int i = C.tid; i < 1024; i += NTHR) ((unsigned*)(KWS() + WS_CTL))[i] = 0u;
    for (int it0 = C.gw; it0 < N_EARLY; it0 += C.NGW) tr_dispatch(it0, scr, C.lane);
    const int gt = C.gw * 64 + C.lane, NGT = C.NGW * 64;
    { float* z = (float*)(KWS() + WS_SSQ) + T; for (int i = gt; i < 5 * T; i += NGT) z[i] = 0.f; }
    { u32x4* z = (u32x4*)(wsW + WO_DOWN + (size_t)704 * D * 2); for (int i = gt; i < 64 * D * 2 / 16; i += NGT) z[i] = (u32x4){0u, 0u, 0u, 0u}; }
    { const float* win = KIN(14); const float* wup = KIN(15); bf16* dst = (bf16*)(wsW + WO_GLAIN) + (size_t)GLA_NPROJ * D;
      for (int i = gt; i < 512 * 128; i += NGT) { const int n = i >> 7, kc = (i & 127) * 8; float up[16];
#pragma unroll
          for (int r = 0; r < 16; ++r) up[r] = wup[r * 512 + n];
          float o[8];
#pragma unroll
          for (int j = 0; j < 8; ++j) { const f32x4* lr = (const f32x4*)(win + (size_t)(kc + j) * 3088 + 3072); float s = 0.f;
#pragma unroll
              for (int q = 0; q < 4; ++q) { const f32x4 v = lr[q]; s += v.x * up[4 * q] + v.y * up[4 * q + 1] + v.z * up[4 * q + 2] + v.w * up[4 * q + 3]; }
              o[j] = s * KIN(9)[kc + j]; }
          u32x4 w; w.x = pk2(o[0], o[1]); w.y = pk2(o[2], o[3]); w.z = pk2(o[4], o[5]); w.w = pk2(o[6], o[7]);
          *(u32x4*)(dst + (size_t)n * D + kc) = w; } }
    { f32x2* tab = (f32x2*)(KWS() + WS_ROPE);
      for (int i = gt; i < SEQ * 32; i += NGT) { const int pos = i >> 5, k = i & 31;
          const double t = (double)pos * c_invfreq[k]; const double TWO_PI = 6.283185307179586476925286766559;
          const double kk = __builtin_rint(t * (1.0 / TWO_PI)); const double x = t - kk * TWO_PI; const double x2 = x * x;
          double sn = -1.0 / 51090942171709440000.0;
          sn = sn * x2 + 1.0 / 121645100408832000.0; sn = sn * x2 - 1.0 / 355687428096000.0; sn = sn * x2 + 1.0 / 1307674368000.0; sn = sn * x2 - 1.0 / 6227020800.0;
          sn = sn * x2 + 1.0 / 39916800.0; sn = sn * x2 - 1.0 / 362880.0; sn = sn * x2 + 1.0 / 5040.0; sn = sn * x2 - 1.0 / 120.0; sn = sn * x2 + 1.0 / 6.0; sn = -sn * x2 + 1.0; sn = sn * x;
          double cs = 1.0 / 2432902008176640000.0;
          cs = cs * x2 - 1.0 / 6402373705728000.0; cs = cs * x2 + 1.0 / 20922789888000.0; cs = cs * x2 - 1.0 / 87178291200.0; cs = cs * x2 + 1.0 / 479001600.0;
          cs = cs * x2 - 1.0 / 3628800.0; cs = cs * x2 + 1.0 / 40320.0; cs = cs * x2 - 1.0 / 720.0; cs = cs * x2 + 1.0 / 24.0; cs = cs * x2 - 0.5; cs = cs * x2 + 1.0;
          tab[i] = (f32x2){(float)cs, (float)sn}; } }
    for (int m = C.gw; m < T; m += C.NGW) {
        const float* src = (m < TP) ? KIN(0) + (size_t)m * D : KIN(1) + (size_t)(m - TP) * D;
        first_row(C, src, (bf16*)(KWS() + WS_HB) + (size_t)m * D, (float*)(KWS() + WS_SSQ) + m);
    }
}

__device__ __forceinline__ void mla_post_phase(const Ctx& C) {
    const float* down = (const float*)(KWS() + WS_BIG + BG_DOWN);
    bf16* cqn = (bf16*)(KWS() + WS_US + US_CQN); bf16* ckvn = (bf16*)(KWS() + WS_US + US_CKVN); bf16* kpeb = (bf16*)(KWS() + WS_US + US_KPEB);
    const float* qn = KIN(20); const float* kvn = KIN(22); const f32x2* rope = (const f32x2*)(KWS() + WS_ROPE);
    const int lane = C.lane;
    for (int m = C.gw; m < T; m += C.NGW) {
        const float* r = down + (size_t)m * 768;
        f32x2 a[3]; float s = 0.f;
#pragma unroll
        for (int j = 0; j < 3; ++j) { a[j] = *(const f32x2*)(r + 2 * lane + 128 * j); s += a[j].x * a[j].x + a[j].y * a[j].y; }
        const float rstd = 1.0f / sqrtf(wave_sum(s) * (1.f / 384.f) + EPS);
#pragma unroll
        for (int j = 0; j < 3; ++j) { const f32x2 g = *(const f32x2*)(qn + 2 * lane + 128 * j); *(unsigned*)(cqn + (size_t)m * 384 + 2 * lane + 128 * j) = pk2(a[j].x * rstd * g.x, a[j].y * rstd * g.y); }
        const f32x4 v = *(const f32x4*)(r + 384 + 4 * lane);
        const float s2 = (v.x * v.x + v.y * v.y) + (v.z * v.z + v.w * v.w);
        const float rstd2 = 1.0f / sqrtf(wave_sum(s2) * (1.f / 256.f) + EPS);
        const f32x4 o = v * rstd2 * *(const f32x4*)(kvn + 4 * lane);
        float* ockv = (m < TP) ? KOUT() + O_CKVP + (size_t)m * 256 : KOUT() + O_CKVS + (size_t)(m - TP) * 256;
        *(f32x4*)(ockv + 4 * lane) = o;
        const int kr = tok_keyrow(m);
        *(u32x2*)(ckvn + (size_t)kr * 256 + 4 * lane) = (u32x2){pk2(o.x, o.y), pk2(o.z, o.w)};
        const int pos = tok_pos(m);
        if (lane < 32) {
            const float x1 = r[640 + lane], x2 = r[672 + lane]; const f32x2 cs = rope[(size_t)pos * 32 + lane];
            const float o1 = x1 * cs.x - x2 * cs.y, o2 = x1 * cs.y + x2 * cs.x;
            float* okpe = (m < TP) ? KOUT() + O_KPEP + (size_t)m * 64 : KOUT() + O_KPES + (size_t)(m - TP) * 64;
            okpe[lane] = o1; okpe[32 + lane] = o2;
            kpeb[(size_t)kr * 64 + lane] = (bf16)f2bf(o1); kpeb[(size_t)kr * 64 + 32 + lane] = (bf16)f2bf(o2);
        }
    }
    const int gt = C.gw * 64 + C.lane, NGT = C.NGW * 64;
    const float* cckv = KIN(3); const float* ckpe = KIN(4);
    for (int i = gt; i < DB * PAST * 40; i += NGT) {
        const int row = i / 40, pc = i - row * 40; const int b = row >> 10, j = row & 1023; const size_t kr = (size_t)TP + b * KSEQS + j;
        const float* src; bf16* dst;
        if (pc < 32) { src = cckv + (size_t)row * 256 + pc * 8; dst = ckvn + kr * 256 + pc * 8; } else { src = ckpe + (size_t)row * 64 + (pc - 32) * 8; dst = kpeb + kr * 64 + (pc - 32) * 8; }
        const f32x4 v0 = *(const f32x4*)src, v1 = *(const f32x4*)(src + 4);
        *(u32x4*)dst = (u32x4){pk2(v0.x, v0.y), pk2(v0.z, v0.w), pk2(v1.x, v1.y), pk2(v1.z, v1.w)};
    }
}

struct GlaSlot { int row0, h, b, hh; bool sample; };
__device__ __forceinline__ GlaSlot gla_slot(int slot, int hf) {
    GlaSlot s;
    if (slot < 1024) { const int sh = slot >> 7, c = slot & 127; s.b = sh >> 1; s.hh = sh & 1; s.row0 = s.b * SEQ + 64 * c; s.sample = false; }
    else { const int q = slot - 1024; s.b = q >> 1; s.hh = q & 1; s.row0 = TP + s.b * DSEQ; s.sample = true; }
    s.h = 2 * hf + s.hh; return s;
}
constexpr int KT_STR = 320, VT_STR = 576, QD_STR = 272, PP_STR = 144, OF_STR = 1040;
__device__ __forceinline__ void gla_pass_a(const Ctx& C, int hf) {
    const bf16* PROJ = (const bf16*)(KWS() + WS_BIG + BG_PROJ); const _Float16* LA = (const _Float16*)(KWS() + WS_BIG + BG_LA);
    bf16* US = (bf16*)(KWS() + WS_US); float* DEC = (float*)(KWS() + WS_DEC);
    LAS unsigned char* KT = C.lds; LAS unsigned char* VT = C.lds + 20480; LAS float* SEG = (LAS float*)(C.lds + 57344);
    const int tid = C.tid, lane = C.lane, w = C.wave, col = tid & 127, seg = tid >> 7;
    const int h2 = lane >> 5, cb = (lane >> 4) & 1, qq = (lane & 15) >> 2, p4 = lane & 3, r32 = lane & 31;
    for (int slot = blockIdx.x; slot < NSLOT; slot += C.G) {
        const GlaSlot S = gla_slot(slot, hf);
        const _Float16* la = LA + (size_t)(S.row0 + 16 * seg) * 512 + S.h * 128 + col;
        const bf16* kp = PROJ + (size_t)(S.row0 + 16 * seg) * GLA_NPROJ + 512 + S.h * 128 + col;
        float cs[16], kv[16]; float run = 0.f;
#pragma unroll
        for (int i = 0; i < 16; ++i) { run += (float)la[(size_t)i * 512]; cs[i] = run; kv[i] = bf2f(kp[(size_t)i * GLA_NPROJ]); }
        SEG[seg * 128 + col] = run;
#pragma unroll
        for (int i = 0; i < 4; ++i) { const int p = tid + 512 * i, r = p >> 5, ch = p & 31;
            const u32x4 v = *(const u32x4*)(PROJ + (size_t)(S.row0 + r) * GLA_NPROJ + 1024 + S.h * 256 + ch * 8);
            *(LAS u32x4*)(VT + r * VT_STR + ch * 16) = v; }
        __syncthreads();
        float pre = 0.f, tot = 0.f;
#pragma unroll
        for (int s = 0; s < 4; ++s) { const float x = SEG[s * 128 + col]; tot += x; if (s < seg) pre += x; }
#pragma unroll
        for (int i = 0; i < 16; ++i) { const float bb = pre + cs[i]; *(LAS bf16*)(KT + (16 * seg + i) * KT_STR + col * 2) = (bf16)f2bf(kv[i] * fast_exp(tot - bb)); }
        if (seg == 0) DEC[(size_t)slot * 128 + col] = fast_exp(tot);
        __syncthreads();
        const int dkt = w & 3, dvg = w >> 2;
        f32x16 acc[4];
#pragma unroll
        for (int j = 0; j < 4; ++j) acc[j] = (f32x16){};
#pragma unroll
        for (int ks = 0; ks < 4; ++ks) {
            const int krow = 16 * ks + 8 * h2 + qq;
            LAS const unsigned char* bp = KT + krow * KT_STR + (32 * dkt + 16 * cb + 4 * p4) * 2;
            const bf16x8 bfr = cat8(ds_tr((LAS const char*)bp), ds_tr((LAS const char*)(bp + 4 * KT_STR)));
#pragma unroll
            for (int j = 0; j < 4; ++j) {
                LAS const unsigned char* ap = VT + krow * VT_STR + (32 * (dvg * 4 + j) + 16 * cb + 4 * p4) * 2;
                const bf16x8 afr = cat8(ds_tr((LAS const char*)ap), ds_tr((LAS const char*)(ap + 4 * VT_STR)));
                acc[j] = MFMA32(afr, bfr, acc[j]);
            }
        }
        bf16* us = US + (size_t)slot * 32768 + (size_t)(32 * dkt + r32) * 256;
#pragma unroll
        for (int j = 0; j < 4; ++j)
#pragma unroll
            for (int g = 0; g < 4; ++g) {
                const int dv = 32 * (dvg * 4 + j) + 8 * g + 4 * h2;
                *(u32x2*)(us + dv) = (u32x2){pk2(acc[j][4 * g], acc[j][4 * g + 1]), pk2(acc[j][4 * g + 2], acc[j][4 * g + 3])};
            }
        __syncthreads();
    }
}
__device__ __forceinline__ void gla_pass_b(const Ctx& C, int hf) {
    bf16* US = (bf16*)(KWS() + WS_US); const float* DEC = (const float*)(KWS() + WS_DEC);
    const int gwv = C.wave * C.G + blockIdx.x;
    const int nwv = NWAVES * C.G;
    const int npw = 512;
    if (gwv < npw) {
        const int gid = gwv * 64 + C.lane; const int sh = gid >> 12, e = gid & 4095, dk = e >> 5;
        const int b = sh >> 1, h = 2 * hf + (sh & 1);
        float S[8];
#pragma unroll
        for (int j = 0; j < 8; ++j) S[j] = 0.f;
        u32x4* up = (u32x4*)(US + (size_t)(sh * 128) * 32768) + e;
        const float* dp = DEC + (size_t)(sh * 128) * 128 + dk;
        u32x4 ua[8], ub[8]; float da[8], db[8];
#define PB_LOAD(U, Dd, c0) do { _Pragma("unroll") for (int k = 0; k < 8; ++k) { U[k] = up[(size_t)((c0) + k) * 4096]; Dd[k] = dp[((c0) + k) * 128]; } } while (0)
#define PB_STEP(U, Dd, c0) do { _Pragma("unroll") for (int k = 0; k < 8; ++k) { const u32x4 u = U[k]; const float d = Dd[k]; \
            u32x4 o; o.x = pk2(S[0], S[1]); o.y = pk2(S[2], S[3]); o.z = pk2(S[4], S[5]); o.w = pk2(S[6], S[7]); up[(size_t)((c0) + k) * 4096] = o; \
            S[0] = d * S[0] + __uint_as_float(u.x << 16); S[1] = d * S[1] + __uint_as_float(u.x & 0xffff0000u); \
            S[2] = d * S[2] + __uint_as_float(u.y << 16); S[3] = d * S[3] + __uint_as_float(u.y & 0xffff0000u); \
            S[4] = d * S[4] + __uint_as_float(u.z << 16); S[5] = d * S[5] + __uint_as_float(u.z & 0xffff0000u); \
            S[6] = d * S[6] + __uint_as_float(u.w << 16); S[7] = d * S[7] + __uint_as_float(u.w & 0xffff0000u); } } while (0)
        PB_LOAD(ua, da, 0);
#pragma unroll 1
        for (int c0 = 0; c0 < 128; c0 += 16) {
            PB_LOAD(ub, db, c0 + 8);
            PB_STEP(ua, da, c0);
            if (c0 + 16 < 128) PB_LOAD(ua, da, c0 + 16);
            PB_STEP(ub, db, c0 + 8);
        }
#undef PB_LOAD
#undef PB_STEP
        float* o = KOUT() + O_GLAP + ((size_t)(b * 4 + h) * 32768) + (size_t)e * 8;
        *(f32x4*)o = (f32x4){S[0], S[1], S[2], S[3]}; *(f32x4*)(o + 4) = (f32x4){S[4], S[5], S[6], S[7]};
    } else {
        const int nsw = nwv - npw;
        for (int q = gwv - npw; q < 64 * 64; q += nsw) {
            const int gid = q * 64 + C.lane; const int ss = gid >> 12, e = gid & 4095, dk = e >> 5;
            const int b = ss >> 1, h = 2 * hf + (ss & 1); const int slot = 1024 + ss;
            const float* s0 = KIN(2) + ((size_t)(b * 4 + h) * 32768) + (size_t)e * 8;
            const f32x4 a0 = *(const f32x4*)s0, a1 = *(const f32x4*)(s0 + 4);
            u32x4* up = (u32x4*)(US + (size_t)slot * 32768) + e; const u32x4 u = *up; const float d = DEC[(size_t)slot * 128 + dk];
            *up = (u32x4){pk2(a0.x, a0.y), pk2(a0.z, a0.w), pk2(a1.x, a1.y), pk2(a1.z, a1.w)};
            float* o = KOUT() + O_GLAS + ((size_t)(b * 4 + h) * 32768) + (size_t)e * 8;
            *(f32x4*)o = (f32x4){d * a0.x + __uint_as_float(u.x << 16), d * a0.y + __uint_as_float(u.x & 0xffff0000u), d * a0.z + __uint_as_float(u.y << 16), d * a0.w + __uint_as_float(u.y & 0xffff0000u)};
            *(f32x4*)(o + 4) = (f32x4){d * a1.x + __uint_as_float(u.z << 16), d * a1.y + __uint_as_float(u.z & 0xffff0000u), d * a1.z + __uint_as_float(u.w << 16), d * a1.w + __uint_as_float(u.w & 0xffff0000u)};
        }
    }
    if (C.wave >= 2) late_weights(C, hf);
}
__device__ __forceinline__ void gla_pass_c(const Ctx& C, int hf) {
    const bf16* PROJ = (const bf16*)(KWS() + WS_BIG + BG_PROJ); const _Float16* LA = (const _Float16*)(KWS() + WS_BIG + BG_LA);
    const bf16* US = (const bf16*)(KWS() + WS_US); bf16* HB = (bf16*)(KWS() + WS_HB); const float* gnorm = KIN(17);
    LAS unsigned char* QD = C.lds; LAS unsigned char* KI = C.lds + 17408; LAS unsigned char* VT = C.lds + 34816; LAS unsigned char* PP = C.lds + 71680;
    LAS float* SEG = (LAS float*)(C.lds + 80896); LAS unsigned char* SS = C.lds + 82944; LAS unsigned char* OF = SS;
    const int tid = C.tid, lane = C.lane, w = C.wave, col = tid & 127, seg = tid >> 7;
    const int h2 = lane >> 5, cb = (lane >> 4) & 1, qq = (lane & 15) >> 2, p4 = lane & 3, r32 = lane & 31;
    for (int slot = blockIdx.x; slot < NSLOT; slot += C.G) {
        const GlaSlot S = gla_slot(slot, hf);
        const _Float16* la = LA + (size_t)(S.row0 + 16 * seg) * 512 + S.h * 128 + col;
        const bf16* qp = PROJ + (size_t)(S.row0 + 16 * seg) * GLA_NPROJ + S.h * 128 + col;
        float cs[16], kv[16], qv[16]; float run = 0.f;
#pragma unroll
        for (int i = 0; i < 16; ++i) { run += (float)la[(size_t)i * 512]; cs[i] = run; qv[i] = bf2f(qp[(size_t)i * GLA_NPROJ]); kv[i] = bf2f(qp[(size_t)i * GLA_NPROJ + 512]); }
        SEG[seg * 128 + col] = run;
#pragma unroll
        for (int i = 0; i < 4; ++i) { const int p = tid + 512 * i, r = p >> 5, ch = p & 31;
            const u32x4 v = *(const u32x4*)(PROJ + (size_t)(S.row0 + r) * GLA_NPROJ + 1024 + S.h * 256 + ch * 8);
            *(LAS u32x4*)(VT + r * VT_STR + ch * 16) = v; }
#pragma unroll
        for (int i = 0; i < 8; ++i) { const int p = tid + 512 * i, r = p >> 5, ch = p & 31;
            const u32x4 v = *(const u32x4*)(US + (size_t)slot * 32768 + r * 256 + ch * 8);
            *(LAS u32x4*)(SS + r * VT_STR + ch * 16) = v; }
        __syncthreads();
        float pre = 0.f;
#pragma unroll
        for (int s = 0; s < 4; ++s) { const float x = SEG[s * 128 + col]; if (s < seg) pre += x; }
#pragma unroll
        for (int i = 0; i < 16; ++i) { const float bb = pre + cs[i]; const int t = 16 * seg + i;
            *(LAS bf16*)(QD + t * QD_STR + col * 2) = (bf16)f2bf(qv[i] * 0.08838834764831845f * fast_exp(bb));
            *(LAS bf16*)(KI + t * QD_STR + col * 2) = (bf16)f2bf(kv[i] * fast_exp(-bb)); }
        __syncthreads();
        if (w < 4) {
            const int st = w >> 1, tt = (w == 0) ? 0 : (w == 3 ? 0 : 1);
            f32x16 sc = (f32x16){};
            if (w < 3) {
#pragma unroll
                for (int ks = 0; ks < 8; ++ks) {
                    const bf16x8 a = *(LAS const bf16x8*)(KI + (32 * st + r32) * QD_STR + (16 * ks + 8 * h2) * 2);
                    const bf16x8 b = *(LAS const bf16x8*)(QD + (32 * tt + r32) * QD_STR + (16 * ks + 8 * h2) * 2);
                    sc = MFMA32(a, b, sc);
                }
            }
            const int t = 32 * tt + r32;
#pragma unroll
            for (int g = 0; g < 4; ++g) { const int s0 = 32 * st + 8 * g + 4 * h2; float v[4];
#pragma unroll
                for (int e = 0; e < 4; ++e) v[e] = (s0 + e <= t) ? sc[4 * g + e] : 0.f;
                *(LAS u32x2*)(PP + t * PP_STR + s0 * 2) = (u32x2){pk2(v[0], v[1]), pk2(v[2], v[3])}; }
        }
        __syncthreads();
        f32x16 oc[2]; oc[0] = (f32x16){}; oc[1] = (f32x16){};
#pragma unroll
        for (int ks = 0; ks < 4; ++ks) {
            LAS const unsigned char* bp = VT + (16 * ks + 8 * h2 + qq) * VT_STR + (32 * w + 16 * cb + 4 * p4) * 2;
            const bf16x8 bfr = cat8(ds_tr((LAS const char*)bp), ds_tr((LAS const char*)(bp + 4 * VT_STR)));
#pragma unroll
            for (int tt = 0; tt < 2; ++tt) { const bf16x8 a = *(LAS const bf16x8*)(PP + (32 * tt + r32) * PP_STR + (16 * ks + 8 * h2) * 2); oc[tt] = MFMA32(a, bfr, oc[tt]); }
        }
#pragma unroll
        for (int ks = 0; ks < 8; ++ks) {
            LAS const unsigned char* bp = SS + (16 * ks + 8 * h2 + qq) * VT_STR + (32 * w + 16 * cb + 4 * p4) * 2;
            const bf16x8 bfr = cat8(ds_tr((LAS const char*)bp), ds_tr((LAS const char*)(bp + 4 * VT_STR)));
#pragma unroll
            for (int tt = 0; tt < 2; ++tt) { const bf16x8 a = *(LAS const bf16x8*)(QD + (32 * tt + r32) * QD_STR + (16 * ks + 8 * h2) * 2); oc[tt] = MFMA32(a, bfr, oc[tt]); }
        }
        __syncthreads();
#pragma unroll
        for (int tt = 0; tt < 2; ++tt)
#pragma unroll
            for (int r = 0; r < 16; ++r) { const int t = 32 * tt + (r & 3) + 8 * (r >> 2) + 4 * h2; *(LAS float*)(OF + t * OF_STR + (32 * w + r32) * 4) = oc[tt][r]; }
        __syncthreads();
        {
            const int t = tid >> 3, part = tid & 7; const int row = S.row0 + t;
            f32x4 v[8]; float ssq = 0.f;
#pragma unroll
            for (int j = 0; j < 8; ++j) { v[j] = *(LAS const f32x4*)(OF + t * OF_STR + (j * 32 + part * 4) * 4); ssq += (v[j].x * v[j].x + v[j].y * v[j].y) + (v[j].z * v[j].z + v[j].w * v[j].w); }
            ssq += __shfl_xor(ssq, 1); ssq += __shfl_xor(ssq, 2); ssq += __shfl_xor(ssq, 4);
            const float rstd = 1.0f / sqrtf(ssq * (1.f / 256.f) + EPS);
            const bf16* gp = PROJ + (size_t)row * GLA_NPROJ + 2048 + S.h * 256; bf16* op = HB + (size_t)row * D + S.h * 256;
#pragma unroll
            for (int j = 0; j < 8; ++j) { const int dv = j * 32 + part * 4; const u32x2 gg = *(const u32x2*)(gp + dv); const f32x4 gn = *(const f32x4*)(gnorm + dv);
                const float g0 = __uint_as_float(gg.x << 16), g1 = __uint_as_float(gg.x & 0xffff0000u), g2 = __uint_as_float(gg.y << 16), g3 = __uint_as_float(gg.y & 0xffff0000u);
                *(u32x2*)(op + dv) = (u32x2){pk2(v[j].x * rstd * gn.x * silu_f(g0), v[j].y * rstd * gn.y * silu_f(g1)), pk2(v[j].z * rstd * gn.z * silu_f(g2), v[j].w * rstd * gn.w * silu_f(g3))}; }
        }
        __syncthreads();
    }
}

constexpr int AK_STR = 400, AV_STR = 320, AKB = 64 * AK_STR, AVB = 64 * AV_STR;
__device__ __forceinline__ void attn_phase(const Ctx& C, int hf) {
    const bf16* Q = (const bf16*)(KWS() + WS_BIG + BG_Q); const bf16* KU = (const bf16*)(KWS() + WS_BIG + BG_KU); const bf16* VU = (const bf16*)(KWS() + WS_BIG + BG_VU);
    const bf16* KPEB = (const bf16*)(KWS() + WS_US + US_KPEB); bf16* O = (bf16*)(KWS() + WS_HB);
    unsigned* ctr = (unsigned*)(KWS() + WS_CTL) + 512 + 256 * hf;
    const int xcd = (int)((unsigned)__builtin_amdgcn_s_getreg((3 << 11) | 20) & 7u);
    LAS unsigned char* KB = C.lds; LAS unsigned char* VB = C.lds + 2 * AKB; LAS int* ITEM = (LAS int*)(C.lds + 2 * AKB + 2 * AVB);
    const int tid = C.tid, lane = C.lane, w = C.wave;
    const int h2 = lane >> 5, cb = (lane >> 4) & 1, qq = (lane & 15) >> 2, p4 = lane & 3, r32 = lane & 31;
    for (;;) {
        if (tid == 0) {
            int got = -1;
            for (int k = 0; k < 8; ++k) { const int q = (xcd + k) & 7; const unsigned idx = atomicAdd(ctr + 16 * q, 1u); if (idx < 80u) { got = q * 80 + (int)idx; break; } }
            ITEM[0] = got;
        }
        __syncthreads();
        const int item = ITEM[0];
        if (item < 0) break;
        int b, hl, keyrow0, qrow0, ntb, ntw;
        { const int q = item / 80, i = item - q * 80;
          if (i < 64) { const int qb = 31 - (i >> 1), combo = 2 * q + (i & 1); b = combo >> 2; hl = combo & 3; keyrow0 = b * SEQ; qrow0 = b * SEQ + 256 * qb; ntb = 4 * qb + 4; ntw = 4 * qb + (w >> 1) + 1; }
          else { const int j = q * 16 + (i - 64); b = j >> 2; hl = j & 3; keyrow0 = TP + b * KSEQS; qrow0 = TP + b * DSEQ; ntb = 17; ntw = (w < 2) ? 17 : 0; } }
        const int head = 4 * hf + hl;
        bf16x8 qf[12];
        if (ntw > 0) {
            const GAS bf16* qp = (const GAS bf16*)(Q + (size_t)(qrow0 + 32 * w + r32) * 1536 + head * 192 + 8 * h2);
#pragma unroll
            for (int ks = 0; ks < 12; ++ks) qf[ks] = *(const GAS bf16x8*)(qp + 16 * ks);
        } else {
#pragma unroll
            for (int ks = 0; ks < 12; ++ks) qf[ks] = (bf16x8){};
        }
        f32x16 o[4];
#pragma unroll
        for (int j = 0; j < 4; ++j) o[j] = (f32x16){};
        float mrun = 0.f, lrun = 0.f;
        const int kr_ = tid >> 4, kc_ = tid & 15, pr_ = tid >> 3, pc_ = tid & 7;
        const GAS bf16* ksrc = (const GAS bf16*)(KU + (size_t)(keyrow0 + kr_) * 512 + hl * 128 + kc_ * 8);
        const GAS bf16* vsrc = (const GAS bf16*)(VU + (size_t)(keyrow0 + kr_) * 512 + hl * 128 + kc_ * 8);
        const GAS bf16* psrc = (const GAS bf16*)(KPEB + (size_t)(keyrow0 + pr_) * 64 + pc_ * 8);
        u32x4 pre[5];
#define ATT_LOAD(t) do { const size_t o_ = (size_t)(t) * 64; pre[0] = *(const GAS u32x4*)(ksrc + o_ * 512); pre[1] = *(const GAS u32x4*)(ksrc + (o_ + 32) * 512); \
        pre[2] = *(const GAS u32x4*)(vsrc + o_ * 512); pre[3] = *(const GAS u32x4*)(vsrc + (o_ + 32) * 512); pre[4] = *(const GAS u32x4*)(psrc + o_ * 64); } while (0)
#define ATT_STORE(bufi) do { LAS unsigned char* kb_ = KB + (bufi) * AKB; LAS unsigned char* vb_ = VB + (bufi) * AVB; \
        *(LAS u32x4*)(kb_ + kr_ * AK_STR + kc_ * 16) = pre[0]; *(LAS u32x4*)(kb_ + (kr_ + 32) * AK_STR + kc_ * 16) = pre[1]; \
        *(LAS u32x4*)(vb_ + kr_ * AV_STR + kc_ * 16) = pre[2]; *(LAS u32x4*)(vb_ + (kr_ + 32) * AV_STR + kc_ * 16) = pre[3]; \
        *(LAS u32x4*)(kb_ + pr_ * AK_STR + 256 + pc_ * 16) = pre[4]; } while (0)
        ATT_LOAD(0); ATT_STORE(0);
        if (ntb > 1) ATT_LOAD(1);
        __syncthreads();
        if (ntw > 0) {
            LAS const unsigned char* kb = KB + r32 * AK_STR + 16 * h2;
            f32x16 sr = (f32x16){};
#pragma unroll
            for (int ks = 0; ks < 12; ++ks) { const bf16x8 a0 = *(LAS const bf16x8*)(kb + ks * 32); sr = MFMA32(a0, qf[ks], sr); }
            float m0 = sr[0];
#pragma unroll
            for (int r = 1; r < 16; ++r) m0 = fmaxf(m0, sr[r]);
            auto rr = __builtin_amdgcn_permlane32_swap(__float_as_uint(m0), __float_as_uint(m0), false, false);
            mrun = fmaxf(__uint_as_float(rr[0]), __uint_as_float(rr[1]));
        }
        for (int t = 0; t < ntb; ++t) {
            const int cur = t & 1;
            LAS const unsigned char* kb = KB + cur * AKB + r32 * AK_STR + 16 * h2; LAS const unsigned char* vb = VB + cur * AVB;
            f32x16 s0, s1; float mx0 = 0.f, mx1 = 0.f, ls = 0.f; bf16x8 pf[4]; bf16x8 kq[3], vq[2];
            if (t < ntw) {
#pragma unroll
                for (int r = 0; r < 16; ++r) { s0[r] = -mrun; s1[r] = -mrun; }
#define ATT_KF(i) (*(LAS const bf16x8*)(kb + ((i) < 12 ? (i) * 32 : 32 * AK_STR + ((i) - 12) * 32)))
#define ATT_VF(i) cat8(ds_tr((LAS const char*)(vb + (16 * ((i) >> 2) + 4 * h2 + qq) * AV_STR + (32 * ((i) & 3) + 16 * cb + 4 * p4) * 2)), ds_tr((LAS const char*)(vb + (16 * ((i) >> 2) + 4 * h2 + qq + 8) * AV_STR + (32 * ((i) & 3) + 16 * cb + 4 * p4) * 2)))
                kq[0] = ATT_KF(0); kq[1] = ATT_KF(1); kq[2] = ATT_KF(2);
                __builtin_amdgcn_sched_barrier(0);
#pragma unroll
                for (int i = 0; i < 24; ++i) {
                    const bf16x8 ac = kq[i % 3];
                    if (i + 3 < 24) kq[i % 3] = ATT_KF(i + 3);
                    if (i == 22) vq[0] = ATT_VF(0);
                    if (i == 23) vq[1] = ATT_VF(1);
                    if (i < 12) s0 = MFMA32(ac, qf[i], s0); else s1 = MFMA32(ac, qf[i - 12], s1);
                    const int ks = i - 12;
                    if (ks == 0) mx0 = fmaxf(fmaxf(fmaxf(s0[0], s0[1]), fmaxf(s0[2], s0[3])), fmaxf(fmaxf(s0[4], s0[5]), fmaxf(s0[6], s0[7])));
                    if (ks == 1) mx0 = fmaxf(mx0, fmaxf(fmaxf(fmaxf(s0[8], s0[9]), fmaxf(s0[10], s0[11])), fmaxf(fmaxf(s0[12], s0[13]), fmaxf(s0[14], s0[15]))));
                    if (ks >= 2 && ks < 10) { const int r = 2 * (ks - 2); s0[r] = __builtin_amdgcn_exp2f(s0[r]); s0[r + 1] = __builtin_amdgcn_exp2f(s0[r + 1]); ls += s0[r] + s0[r + 1]; }
                    if (ks == 10) { const u32x4 x = (u32x4){pk2(s0[0], s0[1]), pk2(s0[2], s0[3]), pk2(s0[4], s0[5]), pk2(s0[6], s0[7])}; pf[0] = __builtin_bit_cast(bf16x8, x); }
                    if (ks == 11) { const u32x4 x = (u32x4){pk2(s0[8], s0[9]), pk2(s0[10], s0[11]), pk2(s0[12], s0[13]), pk2(s0[14], s0[15])}; pf[1] = __builtin_bit_cast(bf16x8, x); }
                    __builtin_amdgcn_sched_barrier(0);
                }
            }
            if (t + 1 < ntb) ATT_STORE(cur ^ 1);
            if (t + 2 < ntb) ATT_LOAD(t + 2);
            if (t < ntw) {
#pragma unroll
                for (int i = 0; i < 16; ++i) {
                    const int kk = i >> 2, j = i & 3;
                    const bf16x8 a = vq[i & 1];
                    if (i + 2 < 16) vq[i & 1] = ATT_VF(i + 2);
                    o[j] = MFMA32(a, pf[kk], o[j]);
                    if (i == 0) mx1 = fmaxf(fmaxf(fmaxf(s1[0], s1[1]), fmaxf(s1[2], s1[3])), fmaxf(fmaxf(s1[4], s1[5]), fmaxf(s1[6], s1[7])));
                    if (i == 1) mx1 = fmaxf(mx1, fmaxf(fmaxf(fmaxf(s1[8], s1[9]), fmaxf(s1[10], s1[11])), fmaxf(fmaxf(s1[12], s1[13]), fmaxf(s1[14], s1[15]))));
                    if (i >= 2 && i < 6) { const int r = 4 * (i - 2);
#pragma unroll
                        for (int e2 = 0; e2 < 4; ++e2) { s1[r + e2] = __builtin_amdgcn_exp2f(s1[r + e2]); ls += s1[r + e2]; } }
                    if (i == 6) { const u32x4 x = (u32x4){pk2(s1[0], s1[1]), pk2(s1[2], s1[3]), pk2(s1[4], s1[5]), pk2(s1[6], s1[7])}; pf[2] = __builtin_bit_cast(bf16x8, x); }
                    if (i == 7) { const u32x4 x = (u32x4){pk2(s1[8], s1[9]), pk2(s1[10], s1[11]), pk2(s1[12], s1[13]), pk2(s1[14], s1[15])}; pf[3] = __builtin_bit_cast(bf16x8, x); }
                    __builtin_amdgcn_sched_barrier(0);
                }
#undef ATT_KF
#undef ATT_VF
                lrun += ls;
                float mx = fmaxf(mx0, mx1);
                { auto rr = __builtin_amdgcn_permlane32_swap(__float_as_uint(mx), __float_as_uint(mx), false, false); mx = fmaxf(__uint_as_float(rr[0]), __uint_as_float(rr[1])); }
                if (__any(mx > 8.0f)) {
                    const float dl = fmaxf(mx, 0.f), alpha = __builtin_amdgcn_exp2f(-dl);
                    mrun += dl; lrun *= alpha;
#pragma unroll
                    for (int j = 0; j < 4; ++j) o[j] *= alpha;
                }
            }
            __syncthreads();
        }
#undef ATT_LOAD
#undef ATT_STORE
        if (ntw > 0) {
            const float l = lrun + __shfl_xor(lrun, 32); const float inv = 1.0f / l;
            GAS bf16* op = (GAS bf16*)(O + (size_t)(qrow0 + 32 * w + r32) * D + head * 128 + 4 * h2);
#pragma unroll
            for (int j = 0; j < 4; ++j)
#pragma unroll
                for (int g = 0; g < 4; ++g)
                    *(GAS u32x2*)(op + 32 * j + 8 * g) = (u32x2){pk2(o[j][4 * g] * inv, o[j][4 * g + 1] * inv), pk2(o[j][4 * g + 2] * inv, o[j][4 * g + 3] * inv)};
        }
    }
}

#define XB_TMO      128
#define XB_XCNT(j)  (256  + 64 * (j))
#define XB_XSUB(j)  (1280 + 64 * (j))
#define XB_XGEN(j)  (2304 + 64 * (j))
#define XB_TOP      3328
#define XB_TOPGEN   3392
#define XCD_BAR_WORDS 3456
#define XB_SPIN_CAP (1u << 18)

__device__ __forceinline__ unsigned xb_ld(unsigned* p)              { return __hip_atomic_load(p, __ATOMIC_RELAXED, __HIP_MEMORY_SCOPE_AGENT); }
__device__ __forceinline__ unsigned xb_add(unsigned* p, unsigned v) { return __hip_atomic_fetch_add(p, v, __ATOMIC_RELAXED, __HIP_MEMORY_SCOPE_AGENT); }
__device__ __forceinline__ unsigned xb_xcc_id() { return (unsigned)__builtin_amdgcn_s_getreg((3 << 11) | 20) & 0xFu; }
#define XB_SPIN(cond, bar) do { unsigned _sp = 0; while (cond) { __builtin_amdgcn_s_sleep(1); \
    if ((++_sp & 255u) == 0u) { if (xb_ld(&(bar)[XB_TMO])) break; if (_sp > XB_SPIN_CAP) { atomicAdd(&(bar)[XB_TMO], 1u); break; } } } } while (0)

struct XcdBarrier {
    unsigned* bar; unsigned x;
    volatile LAS unsigned* st;
};

__device__ __forceinline__ XcdBarrier xcd_barrier_post(unsigned* bar, volatile LAS unsigned* st) {
    XcdBarrier b; b.bar = bar; b.x = xb_xcc_id(); b.st = st;
    if (threadIdx.x == 0) (void)xb_add(&bar[XB_XCNT(b.x)], 1u);
    return b;
}
__device__ __forceinline__ void xcd_barrier_complete(unsigned* bar, unsigned x, unsigned& nloc, unsigned& nx) {
    const unsigned G = gridDim.x * gridDim.y * gridDim.z;
    unsigned sum, cnt, mine, sp = 0u;
    for (;;) {
        sum = 0u; cnt = 0u; mine = 0u;
#pragma unroll
        for (unsigned j = 0; j < 16; ++j) { const unsigned c = xb_ld(&bar[XB_XCNT(j)]); sum += c; cnt += (c > 0u) ? 1u : 0u; mine = (j == x) ? c : mine; }
        if (sum == G) break;
        __builtin_amdgcn_s_sleep(1);
        if ((++sp & 255u) == 0u) { if (xb_ld(&bar[XB_TMO])) break; if (sp > XB_SPIN_CAP) { atomicAdd(&bar[XB_TMO], 1u); break; } }
    }
    nloc = mine > 0u ? mine : 1u; nx = cnt > 0u ? cnt : 1u;
}

__device__ __forceinline__ void xcd_barrier(const XcdBarrier& b) {
    asm volatile("s_waitcnt vmcnt(0)" ::: "memory");
    __syncthreads();
    if (threadIdx.x == 0) {
        unsigned* bar = b.bar;
        __builtin_amdgcn_s_waitcnt(0);
        unsigned nloc = b.st[0], nx = b.st[1];
        if (nloc == 0u) { xcd_barrier_complete(bar, b.x, nloc, nx); b.st[0] = nloc; b.st[1] = nx; }
        const unsigned old = xb_add(&bar[XB_XSUB(b.x)], 1u);
        const unsigned gen = old / nloc;
        if (old + 1u == (gen + 1u) * nloc) {
            __builtin_amdgcn_fence(__ATOMIC_RELEASE, "agent");
            asm volatile("s_waitcnt vmcnt(0)" ::: "memory");
            const unsigned og = xb_add(&bar[XB_TOP], 1u);
            const unsigned tg = og / nx;
            if (og + 1u == (tg + 1u) * nx) xb_add(&bar[XB_TOPGEN], 1u);
            else XB_SPIN(xb_ld(&bar[XB_TOPGEN]) == tg, bar);
            __builtin_amdgcn_fence(__ATOMIC_ACQUIRE, "agent");
            xb_add(&bar[XB_XGEN(b.x)], 1u);
            asm volatile("s_waitcnt vmcnt(0)" ::: "memory");
        } else {
            XB_SPIN(xb_ld(&bar[XB_XGEN(b.x)]) == gen, bar);
            __builtin_amdgcn_fence(__ATOMIC_ACQUIRE, "agent");
            asm volatile("s_waitcnt vmcnt(0)" ::: "memory");
        }
    }
    __syncthreads();
}

using EpiResidFirst = EpiResid<true, true>;
struct Args { const float* in[27]; float* out; unsigned char* ws; int ph_lo, ph_hi; };
constexpr int NPHASE = 30;

__global__ void __launch_bounds__(NTHR, 2) mega_fwd(Args args) {
    extern __shared__ __attribute__((aligned(16))) unsigned char lds_raw[];
    Ctx C;
    C.lds = (LAS unsigned char*)lds_raw; C.tid = threadIdx.x; C.lane = C.tid & 63; C.wave = __builtin_amdgcn_readfirstlane(C.tid >> 6);
    C.G = gridDim.x; C.gw = blockIdx.x * NWAVES + C.wave; C.NGW = C.G * NWAVES;
#define ws KWS()
#define wsW (KWS() + WS_W)
#define X (KOUT() + O_Y)
#define HB ((bf16*)(KWS() + WS_HB))
    const int lo = args.ph_lo, hi = args.ph_hi;
    int ph = 0;
#if ONE_LAUNCH
    cg::grid_group grid = cg::this_grid();
    volatile LAS unsigned* bst = (volatile LAS unsigned*)(C.lds + LDS_BYTES - 64);
    if (C.tid < 2) bst[C.tid] = 0u;
    __syncthreads();
    XcdBarrier xbar = xcd_barrier_post((unsigned*)(KWS() + WS_BAR), bst);
#define SEAM() do { xcd_barrier(xbar); } while (0)
    if (lo > (1 << 28)) grid.sync();
#else
#define SEAM() do { } while (0)
#endif
#define PHASE_BEGIN if (ph >= lo && ph < hi) {
#define PHASE_END   if (ph + 1 < hi) SEAM(); } ++ph;

    PHASE_BEGIN prologue(C); PHASE_END
#define GEMM_PHASE_S(SCHED, EPI, A_, BT_, M_, N_, K_, ...) PHASE_BEGIN { pg8::Gemm g{(const bf16*)(A_), (const bf16*)(BT_), M_, N_, K_}; pg8::SCHED S; S.init(M_, N_, K_, C.G, (int)blockIdx.x); \
        EPI E{__VA_ARGS__}; pg8::gemm_phase<EPI, pg8::SCHED, true, true>(C.lds, g, S, E); } PHASE_END
#define GEMM_PHASE(...) GEMM_PHASE_S(StaticOrder, __VA_ARGS__)
#define R1 ((bf16*)(ws + WS_HB))
#define R2 ((bf16*)(ws + WS_US))
#define SSQ(i) ((float*)(ws + WS_SSQ) + (size_t)(i) * T)
#define PART_FFN ((float*)(ws + WS_US))
#define PART_MIX ((float*)(ws + WS_BIG))
#define FIXUP_PHASE(xb_, i_, P_, ps_) PHASE_BEGIN fixup_phase(C, X, xb_, SSQ(i_), P_, ps_, nullptr); PHASE_END
#define FFN_PHASES(f, xin, si, so, EPIR) \
    GEMM_PHASE(EpiSwiglu, xin, wsW + WO_FFN + (f) * FFN_B, T, 2 * FF, D, (bf16*)(ws + WS_BIG + BG_ACT), SSQ(si)) \
    GEMM_PHASE_S(SplitOrder, EPIR, ws + WS_BIG + BG_ACT, wsW + WO_FFN + (f) * FFN_B + W1T_B, T, D, FF, X, 0.5f, PART_FFN, R1, SSQ(so), KIN(0), KIN(1))
    FFN_PHASES(0, R1, 0, 1, EpiResidFirst)
    PHASE_BEGIN fixup_phase(C, X, R1, SSQ(1), PART_FFN, 0.5f, KIN(1)); PHASE_END
    GEMM_PHASE(EpiGlaIn, R1, wsW + WO_GLAIN, T, GLA_N, D, (bf16*)(ws + WS_BIG + BG_PROJ), (_Float16*)(ws + WS_BIG + BG_LA), KIN(16), SSQ(1))
    PHASE_BEGIN gla_pass_a(C, 0); PHASE_END
    PHASE_BEGIN gla_pass_b(C, 0); PHASE_END
    PHASE_BEGIN gla_pass_c(C, 0); PHASE_END
    PHASE_BEGIN gla_pass_a(C, 1); PHASE_END
    PHASE_BEGIN gla_pass_b(C, 1); PHASE_END
    PHASE_BEGIN gla_pass_c(C, 1); PHASE_END
    GEMM_PHASE_S(SplitOrder, EpiResid<true>, R1, wsW + WO_GLAOUT, T, D, D, X, 1.0f, PART_MIX, R2, SSQ(2), nullptr, nullptr)
    FIXUP_PHASE(R2, 2, PART_MIX, 1.0f)
    FFN_PHASES(1, R2, 2, 3, EpiResid<true>)
    FIXUP_PHASE(R1, 3, PART_FFN, 0.5f)
    FFN_PHASES(2, R1, 3, 4, EpiResid<true>)
    FIXUP_PHASE(R1, 4, PART_FFN, 0.5f)
    GEMM_PHASE(EpiF32, R1, wsW + WO_DOWN, T, 768, D, (float*)(ws + WS_BIG + BG_DOWN), 768, SSQ(4))
    PHASE_BEGIN mla_post_phase(C); PHASE_END
    PHASE_BEGIN
        { pg8::Gemm g{(const bf16*)(ws + WS_US + US_CQN), (const bf16*)(wsW + WO_UQ), T, 1024, 384}; pg8::StaticOrder S; S.init(T, 1024, 384, C.G, (int)blockIdx.x);
          EpiQ<false> E{(bf16*)(ws + WS_BIG + BG_Q), (const f32x2*)(ws + WS_ROPE)}; pg8::gemm_phase<EpiQ<false>, pg8::StaticOrder, true, true>(C.lds, g, S, E); }
        { pg8::Gemm g{(const bf16*)(ws + WS_US + US_CQN), (const bf16*)(wsW + WO_UQ + (size_t)1024 * 384 * 2), T, 512, 384}; pg8::StaticOrder S; S.init(T, 512, 384, C.G, (int)blockIdx.x);
          EpiQ<true> E{(bf16*)(ws + WS_BIG + BG_Q), (const f32x2*)(ws + WS_ROPE)}; pg8::gemm_phase<EpiQ<true>, pg8::StaticOrder, true, true>(C.lds, g, S, E); }
        { pg8::Gemm g{(const bf16*)(ws + WS_US + US_CKVN), (const bf16*)(wsW + WO_KVUP), TK, 1024, 256}; pg8::StaticOrder S; S.init(TK, 1024, 256, C.G, (int)blockIdx.x);
          EpiKV E{(bf16*)(ws + WS_BIG + BG_KU), (bf16*)(ws + WS_BIG + BG_VU)}; pg8::gemm_phase<EpiKV, pg8::StaticOrder, true, true>(C.lds, g, S, E); }
    PHASE_END
    PHASE_BEGIN attn_phase(C, 0); PHASE_END
    GEMM_PHASE(EpiKV, ws + WS_US + US_CKVN, wsW + WO_KVUP + (size_t)1024 * 256 * 2, TK, 1024, 256, (bf16*)(ws + WS_BIG + BG_KU), (bf16*)(ws + WS_BIG + BG_VU))
    PHASE_BEGIN attn_phase(C, 1); PHASE_END
    GEMM_PHASE_S(SplitOrder, EpiResid<true>, R1, wsW + WO_MLAOUT, T, D, D, X, 1.0f, PART_MIX, R2, SSQ(5), nullptr, nullptr)
    FIXUP_PHASE(R2, 5, PART_MIX, 1.0f)
    FFN_PHASES(3, R2, 5, 5, EpiResid<false>)
    PHASE_BEGIN final_norm_phase(C, X, KIN(26), (const float*)PART_FFN, 0.5f); PHASE_END
#undef ws
#undef wsW
#undef X
#undef HB
}

extern "C" void kernel_launch(void* const* d_in, const int* in_sizes, int n_in, void* d_out, int out_size, void* d_ws, size_t ws_size, hipStream_t stream) {
    static int grid = 0;
    if (grid == 0) {
        if (n_in != 27 || ws_size < WS_END) { fprintf(stderr, "kernel_launch: unexpected n_in %d / ws_size %zu\n", n_in, ws_size); grid = -1; return; }
        int dev = 0, cus = 0, per_cu = 0;
        hipGetDevice(&dev); hipDeviceGetAttribute(&cus, hipDeviceAttributeMultiprocessorCount, dev);
        if (hipFuncSetAttribute((const void*)mega_fwd, hipFuncAttributeMaxDynamicSharedMemorySize, LDS_BYTES) != hipSuccess) { fprintf(stderr, "kernel_launch: hipFuncSetAttribute failed\n"); grid = -1; return; }
        if (hipOccupancyMaxActiveBlocksPerMultiprocessor(&per_cu, (const void*)mega_fwd, NTHR, LDS_BYTES) != hipSuccess || per_cu < 1) { fprintf(stderr, "kernel_launch: occupancy query gave %d\n", per_cu); per_cu = 1; }
        (void)hipGetLastError();
        grid = cus * 1;
    }
    if (grid < 0) return;
    Args a{};
    for (int i = 0; i < 27; ++i) a.in[i] = (const float*)d_in[i];
    a.out = (float*)d_out; a.ws = (unsigned char*)d_ws;
#if ONE_LAUNCH
    a.ph_lo = 0; a.ph_hi = NPHASE;
    if (hipMemsetAsync((char*)d_ws + WS_BAR, 0, XCD_BAR_WORDS * 4, stream) != hipSuccess) { fprintf(stderr, "kernel_launch: memset failed\n"); return; }
    void* kargs[] = {&a};
    hipError_t e = hipLaunchCooperativeKernel((const void*)mega_fwd, dim3(grid), dim3(NTHR), kargs, LDS_BYTES, stream);
    if (e != hipSuccess) fprintf(stderr, "cooperative launch failed: %s (grid %d)\n", hipGetErrorString(e), grid);
#else
    for (int p = 0; p < NPHASE; ++p) { a.ph_lo = p; a.ph_hi = p + 1; hipLaunchKernelGGL(mega_fwd, dim3(grid), dim3(NTHR), LDS_BYTES, stream, a); }
#endif
}
```

```cpp
#include <hip/hip_runtime.h>
#include <hip/hip_cooperative_groups.h>
#include <cstdio>
#include <cstdint>
namespace cg = cooperative_groups;

#ifndef ONE_LAUNCH
#define ONE_LAUNCH 1
#endif

namespace pg8 {
#define PG8_LAS __attribute__((address_space(3)))
typedef unsigned short bf16_t;
typedef short bf16x8 __attribute__((ext_vector_type(8)));
typedef float f32x4 __attribute__((ext_vector_type(4)));
typedef unsigned u32x4 __attribute__((ext_vector_type(4)));
constexpr int BM = 256, BK = 64, HALF = 128, HTB = HALF * BK * 2  , STAGE_BYTES = 8 * HTB, NXCD = 8, WGM = 8;

__host__ __device__ __forceinline__ int lds_byte(int r, int c) { const int st = (r >> 4) * 2 + (c >> 5), rr = r & 15, cc = c & 31, ob = rr * 64 + cc * 2; return st * 1024 + (ob ^ (((ob >> 9) & 1) << 5)); }
__host__ __device__ __forceinline__ void stage_rc(int b, int& R, int& C) { const int st = b / 1024, sb = b % 1024, swz = sb ^ (((sb >> 9) & 1) << 5); R = (st >> 1) * 16 + swz / 64; C = (st & 1) * 32 + (swz % 64) / 2; }
__host__ __device__ __forceinline__ int perm32(int rho) { const int n = rho >> 4, i = rho & 15; return 8 * (i >> 2) + 4 * n + (i & 3); }

struct Unit { int pm, pn, k0, nt, part; };
struct Gemm { const bf16_t* A; const bf16_t* Bt; int M, N, K; };

struct StaticOrder {
    int nM, nN, nwg, G, c;
    int ntK;
    __host__ __device__ void init(int M, int N, int K, int G_, int c_) { nM = M / BM; nN = N / BM; nwg = nM * nN; G = G_; c = c_; ntK = K / BK; }
    __host__ __device__ bool next(int i, Unit& u) const {
        const long L = (long)i * G + c; if (L >= nwg) return false;
        int wgid = (int)L; { const int q = nwg / NXCD, r = nwg % NXCD, xcd = wgid % NXCD, off = wgid / NXCD; wgid = (xcd < r ? xcd * (q + 1) : r * (q + 1) + (xcd - r) * q) + off; }
        const int nig = WGM * nN, gid = wgid / nig, fm = gid * WGM, gsz = (nM - fm) < WGM ? (nM - fm) : WGM;
        u.pm = fm + ((wgid % nig) % gsz); u.pn = (wgid % nig) / gsz; u.k0 = 0; u.nt = ntK; u.part = -1; return true;
    }
    __device__ __forceinline__ void a_ready(const Unit&) const {}
    __device__ __forceinline__ void done(const Unit&) const {}
};

struct SplitOrder {
    StaticOrder full; int G, c, ntK; bool split;
    __host__ __device__ void init(int M, int N, int K, int G_, int c_) { G = G_; c = c_; ntK = K / BK; split = (G_ == 256 && N == 1024 && M == 34816); full.init(split ? 32768 : M, N, K, G_, c_); }
    __host__ __device__ bool next(int i, Unit& u) const {
        if (!split) return full.next(i, u);
        if (i < 2) return full.next(i, u);
        if (i > 2) return false;
        const int ru = c >> 3, part = c & 7, np = ntK >> 1; const int p0 = part * np / 8, p1 = (part + 1) * np / 8;
        u.pm = 128 + (ru >> 2); u.pn = ru & 3; u.k0 = 2 * p0; u.nt = 2 * (p1 - p0); u.part = part; return true;
    }
    __device__ __forceinline__ void a_ready(const Unit&) const {}
    __device__ __forceinline__ void done(const Unit&) const {}
};

__device__ __forceinline__ unsigned cvt_pk_bf16(float lo, float hi) { unsigned r; asm volatile("v_cvt_pk_bf16_f32 %0, %1, %2" : "=v"(r) : "v"(lo), "v"(hi)); return r; }
typedef float f32x2 __attribute__((ext_vector_type(2)));
template <class Epi, class Sched, bool ALIGN_EPI = false, bool SP2 = false>
__device__ __forceinline__ void gemm_phase(PG8_LAS unsigned char* lds, const Gemm g, const Sched& S, const Epi& E) {
    const int tid = threadIdx.x, wid = __builtin_amdgcn_readfirstlane(tid >> 6), lane = tid & 63, wr = wid >> 2, wc = wid & 3, fr = lane & 15, fq = lane >> 4;
    const int K = g.K;
    unsigned voffA[2], voffB[2];
#pragma unroll
    for (int i = 0; i < 2; ++i) { int R, C; stage_rc(tid * 16 + i * 8192, R, C); const int Rb = Epi::PERM ? ((R & ~31) + perm32(R & 31)) : R;
        voffA[i] = (unsigned)(R * K + C) * 2u; voffB[i] = (unsigned)(Rb * K + C) * 2u; }
    const size_t kstep = (size_t)(BK * 2);
    const size_t hstep = (size_t)HALF * K * 2;
    const size_t tstep = 2 * hstep;
    const unsigned ldsw = (unsigned)wid * 1024u;
    const int aoff = lds_byte(wr * 64 + fr, fq * 8), boff = lds_byte(wc * 32 + fr, fq * 8);
#define PG8_SA(b, h) (((b) * 2 + (h)) * HTB)
#define PG8_SB(b, h) ((4 + (b) * 2 + (h)) * HTB)
#define PG8_STAGE(bufoff, gbase, voff) do { _Pragma("unroll") for (int _i = 0; _i < 2; ++_i) \
        __builtin_amdgcn_global_load_lds((const unsigned*)((const char*)(gbase) + (voff)[_i]), (PG8_LAS unsigned*)(lds + (bufoff) + ldsw + _i * 8192), 16, 0, 0); } while (0)
#define PG8_LDA(dst, b, h) do { _Pragma("unroll") for (int m = 0; m < 4; ++m) _Pragma("unroll") for (int k = 0; k < 2; ++k) dst[m][k] = *(const PG8_LAS bf16x8*)(lds + PG8_SA(b, h) + aoff + m * 2048 + k * 1024); } while (0)
#define PG8_LDB(dst, b, h) do { _Pragma("unroll") for (int n = 0; n < 2; ++n) _Pragma("unroll") for (int k = 0; k < 2; ++k) dst[n][k] = *(const PG8_LAS bf16x8*)(lds + PG8_SB(b, h) + boff + n * 2048 + k * 1024); } while (0)
#define PG8_MMA(ai, bj, At, Bt) do { __builtin_amdgcn_s_setprio(1); _Pragma("unroll") for (int m = 0; m < 4; ++m) _Pragma("unroll") for (int n = 0; n < 2; ++n) _Pragma("unroll") for (int k = 0; k < 2; ++k) \
        acc[ai][bj][m][n] = __builtin_amdgcn_mfma_f32_16x16x32_bf16(Bt[n][k], At[m][k], acc[ai][bj][m][n], 0, 0, 0); __builtin_amdgcn_s_setprio(0); } while (0)
#define PG8_WAIT_V(n) asm volatile("s_waitcnt vmcnt(" #n ")" ::: "memory")
#define PG8_WAIT_L(n) asm volatile("s_waitcnt lgkmcnt(" #n ")" ::: "memory")
#define PG8_BAR __builtin_amdgcn_s_barrier()
#define PG8_SCHED __builtin_amdgcn_sched_barrier(0)
    Unit cur, nxt; int ui = 0;
    if (!S.next(0, cur)) return;
    float er[8];
#pragma unroll
    for (int i = 0; i < 8; ++i) er[i] = 0.f;
    f32x4 acc[2][2][4][2];
#pragma unroll
    for (int a = 0; a < 2; ++a)
#pragma unroll
        for (int b = 0; b < 2; ++b)
#pragma unroll
            for (int m = 0; m < 4; ++m)
#pragma unroll
                for (int n = 0; n < 2; ++n) acc[a][b][m][n] = (f32x4){0.f, 0.f, 0.f, 0.f};
    bf16x8 At[4][2], B0[2][2], B1[2][2];
    const char* cA = (const char*)g.A + (size_t)cur.pm * tstep + (size_t)cur.k0 * kstep; const char* cB = (const char*)g.Bt + (size_t)cur.pn * tstep + (size_t)cur.k0 * kstep;
    S.a_ready(cur);
    if constexpr (SP2) {
        PG8_STAGE(PG8_SB(0, 0), cB, voffB); PG8_STAGE(PG8_SB(0, 1), cB + hstep, voffB); PG8_STAGE(PG8_SA(0, 0), cA, voffA); PG8_STAGE(PG8_SA(0, 1), cA + hstep, voffA);
        if (wr == 1) PG8_BAR;
        PG8_WAIT_V(2); PG8_BAR;
        PG8_STAGE(PG8_SB(1, 0), cB + kstep, voffB); PG8_STAGE(PG8_SA(1, 0), cA + kstep, voffA); PG8_STAGE(PG8_SB(1, 1), cB + hstep + kstep, voffB);
        PG8_WAIT_V(6); PG8_BAR;
    } else {
        PG8_STAGE(PG8_SB(0, 0), cB, voffB); PG8_STAGE(PG8_SA(0, 0), cA, voffA); PG8_STAGE(PG8_SB(0, 1), cB + hstep, voffB); PG8_STAGE(PG8_SA(0, 1), cA + hstep, voffA);
        if (wr == 1) PG8_BAR;
        PG8_WAIT_V(4); PG8_BAR;
        PG8_STAGE(PG8_SB(1, 0), cB + kstep, voffB); PG8_STAGE(PG8_SA(1, 0), cA + kstep, voffA); PG8_STAGE(PG8_SB(1, 1), cB + hstep + kstep, voffB);
        PG8_WAIT_V(6); PG8_BAR;
    }
    for (;;) {
        const bool has_next = S.next(ui + 1, nxt);
        const char* nA = has_next ? (const char*)g.A + (size_t)nxt.pm * tstep + (size_t)nxt.k0 * kstep : cA; const char* nB = has_next ? (const char*)g.Bt + (size_t)nxt.pn * tstep + (size_t)nxt.k0 * kstep : cB;
        const int nt = cur.nt;
_Pragma("nounroll")
        for (int t = 0; t < nt; t += 2) {
            const bool last = (t == nt - 2);
            if (last) E.preload(er, cur, wr, fr);
            const char* a1 = cA + (size_t)(t + 1) * kstep;
            const char* a2 = last ? nA : cA + (size_t)(t + 2) * kstep; const char* b2 = last ? nB : cB + (size_t)(t + 2) * kstep;
            const char* a3 = a2 + kstep; const char* b3 = b2 + kstep;
            if (last && has_next) S.a_ready(nxt);
            if constexpr (SP2) {
            PG8_LDB(B0, 0, 0); PG8_LDB(B1, 0, 1); PG8_SCHED; PG8_LDA(At, 0, 0); PG8_STAGE(PG8_SA(1, 1), a1 + hstep, voffA);
            PG8_WAIT_V(8); PG8_WAIT_L(0); PG8_BAR; PG8_MMA(0, 0, At, B0); PG8_MMA(0, 1, At, B1); PG8_BAR; PG8_SCHED;
            PG8_LDA(At, 0, 1); PG8_STAGE(PG8_SB(0, 0), b2, voffB); PG8_STAGE(PG8_SB(0, 1), b2 + hstep, voffB); PG8_STAGE(PG8_SA(0, 0), a2, voffA);
            PG8_WAIT_V(8); PG8_WAIT_L(0); PG8_BAR; PG8_MMA(1, 0, At, B0); PG8_MMA(1, 1, At, B1); PG8_BAR; PG8_SCHED;
            PG8_LDB(B0, 1, 0); PG8_LDB(B1, 1, 1); PG8_SCHED; PG8_LDA(At, 1, 0); PG8_STAGE(PG8_SA(0, 1), a2 + hstep, voffA);
            PG8_WAIT_V(8); PG8_WAIT_L(0); PG8_BAR; PG8_MMA(0, 0, At, B0); PG8_MMA(0, 1, At, B1); PG8_BAR; PG8_SCHED;
            PG8_LDA(At, 1, 1); PG8_STAGE(PG8_SB(1, 0), b3, voffB); PG8_STAGE(PG8_SB(1, 1), b3 + hstep, voffB); PG8_STAGE(PG8_SA(1, 0), a3, voffA);
            PG8_WAIT_V(8); PG8_WAIT_L(0); PG8_BAR; PG8_MMA(1, 0, At, B0); PG8_MMA(1, 1, At, B1); PG8_BAR; PG8_SCHED;
            } else {
            PG8_LDB(B0, 0, 0); PG8_SCHED; PG8_LDA(At, 0, 0); PG8_STAGE(PG8_SA(1, 1), a1 + hstep, voffA);
            PG8_WAIT_L(8); PG8_BAR; PG8_WAIT_L(0); PG8_MMA(0, 0, At, B0); PG8_BAR; PG8_SCHED;
            PG8_LDB(B1, 0, 1); PG8_STAGE(PG8_SB(0, 0), b2, voffB);
            PG8_BAR; PG8_WAIT_L(0); PG8_MMA(0, 1, At, B1); PG8_BAR;
            PG8_LDA(At, 0, 1); PG8_STAGE(PG8_SA(0, 0), a2, voffA);
            PG8_BAR; PG8_WAIT_L(0); PG8_MMA(1, 0, At, B0); PG8_BAR; PG8_SCHED;
            PG8_STAGE(PG8_SB(0, 1), b2 + hstep, voffB);
            PG8_WAIT_V(6); PG8_BAR; PG8_MMA(1, 1, At, B1); PG8_BAR;
            PG8_LDB(B0, 1, 0); PG8_SCHED; PG8_LDA(At, 1, 0); PG8_STAGE(PG8_SA(0, 1), a2 + hstep, voffA);
            PG8_WAIT_L(8); PG8_BAR; PG8_WAIT_L(0); PG8_MMA(0, 0, At, B0); PG8_BAR; PG8_SCHED;
            PG8_LDB(B1, 1, 1); PG8_STAGE(PG8_SB(1, 0), b3, voffB);
            PG8_BAR; PG8_WAIT_L(0); PG8_MMA(0, 1, At, B1); PG8_BAR;
            PG8_LDA(At, 1, 1); PG8_STAGE(PG8_SA(1, 0), a3, voffA);
            PG8_BAR; PG8_WAIT_L(0); PG8_MMA(1, 0, At, B0); PG8_BAR; PG8_SCHED;
            PG8_STAGE(PG8_SB(1, 1), b3 + hstep, voffB);
            PG8_WAIT_V(6); PG8_BAR; PG8_MMA(1, 1, At, B1); PG8_BAR;
            }
        }
        if constexpr (ALIGN_EPI) { if (wr == 0) PG8_BAR; }
        if constexpr (!Epi::AFTER_DRAIN) { E(acc, cur, wr, wc, fr, fq, er); S.done(cur); }
        if (!has_next) break;
#pragma unroll
        for (int a = 0; a < 2; ++a)
#pragma unroll
            for (int b = 0; b < 2; ++b)
#pragma unroll
                for (int m = 0; m < 4; ++m)
#pragma unroll
                    for (int n = 0; n < 2; ++n) acc[a][b][m][n] = (f32x4){0.f, 0.f, 0.f, 0.f};
        cur = nxt; cA = nA; cB = nB; ++ui;
        if constexpr (ALIGN_EPI) { if (wr == 1) PG8_BAR; }
    }
    PG8_WAIT_V(0);
    if constexpr (!ALIGN_EPI) { if (wr == 0) PG8_BAR; }
    PG8_BAR;
    if constexpr (Epi::AFTER_DRAIN) { E.fused(acc, cur, wr, wc, fr, fq, lds, wid, lane); S.done(cur); }
#undef PG8_SA
#undef PG8_SB
#undef PG8_STAGE
#undef PG8_LDA
#undef PG8_LDB
#undef PG8_MMA
#undef PG8_WAIT_V
#undef PG8_WAIT_L
#undef PG8_BAR
#undef PG8_SCHED
}
}

#define GAS __attribute__((address_space(1)))
#define LAS __attribute__((address_space(3)))
typedef unsigned short bf16;
typedef float f32x4 __attribute__((ext_vector_type(4)));
typedef float f32x2 __attribute__((ext_vector_type(2)));
typedef float f32x16 __attribute__((ext_vector_type(16)));
typedef short bf16x8 __attribute__((ext_vector_type(8)));
typedef short s16x4 __attribute__((ext_vector_type(4)));
typedef unsigned u32x4 __attribute__((ext_vector_type(4)));
typedef unsigned u32x2 __attribute__((ext_vector_type(2)));

constexpr int NWAVES = 8, NTHR = 512;
constexpr int D = 1024, FF = 2816, TP = 32768, TS = 2048, T = TP + TS;
constexpr int SEQ = 8192, NB = 4, DB = 32, DSEQ = 64, PAST = 1024, KSEQS = PAST + DSEQ;
constexpr int TK = TP + DB * KSEQS;
constexpr float EPS = 1e-6f;
constexpr int GLA_NPROJ = 3072, GLA_N = 3584;
constexpr int NSLOT = 1088;
constexpr float QSCALE = 0.07216878364870322f * 1.4426950408889634f;

constexpr size_t O_Y = 0, O_GLAP = 35651584, O_CKVP = 36175872, O_KPEP = 44564480, O_GLAS = 46661632, O_CKVS = 50855936, O_KPES = 51380224;
constexpr size_t MiB = 1u << 20;
constexpr size_t WS_CTL = 0, WS_ROPE = 1 * MiB, WS_DEC = 3 * MiB, WS_W = 4 * MiB, WS_HB = 88 * MiB, WS_US = 156 * MiB, WS_BIG = 224 * MiB, WS_END = 462 * MiB;
constexpr size_t W1T_B = (size_t)2 * FF * D * 2, W2T_B = (size_t)D * FF * 2, FFN_B = W1T_B + W2T_B;
constexpr size_t WO_FFN = 0, WO_GLAIN = 4 * FFN_B, WO_GLAOUT = WO_GLAIN + (size_t)GLA_N * D * 2, WO_DOWN = WO_GLAOUT + (size_t)D * D * 2,
                 WO_UQ = WO_DOWN + (size_t)768 * D * 2, WO_KVUP = WO_UQ + (size_t)1536 * 384 * 2, WO_MLAOUT = WO_KVUP + (size_t)2 * 1024 * 256 * 2, WO_END = WO_MLAOUT + (size_t)D * D * 2;
static_assert(WO_END <= 84 * MiB, "weights");
constexpr size_t US_CQN = 0, US_CKVN = (size_t)T * 384 * 2, US_KPEB = US_CKVN + (size_t)TK * 256 * 2;
static_assert(US_KPEB + (size_t)TK * 64 * 2 <= 68 * MiB, "US");
constexpr size_t BG_ACT = 0, BG_PROJ = 0, BG_LA = (size_t)T * GLA_NPROJ * 2, BG_DOWN = 0, BG_Q = 0, BG_KU = (size_t)T * 1536 * 2, BG_VU = BG_KU + (size_t)TK * 512 * 2;
static_assert(BG_VU + (size_t)TK * 512 * 2 <= 238 * MiB && BG_LA + (size_t)T * 512 * 2 <= 238 * MiB, "BIG");
constexpr size_t WS_BAR = 16 * 1024;
constexpr size_t WS_SSQ = 128 * 1024;
static_assert(WS_SSQ + (size_t)6 * T * 4 <= MiB, "ssq");
constexpr int LDS_BYTES = 160 * 1024;

__device__ __forceinline__ unsigned f2bf(float f) { unsigned u = __builtin_bit_cast(unsigned, f); return (u + 0x7fffu + ((u >> 16) & 1u)) >> 16; }
__device__ __forceinline__ unsigned pk2(float lo, float hi) { return pg8::cvt_pk_bf16(lo, hi); }
__device__ __forceinline__ float bf2f(bf16 b) { return __uint_as_float(((unsigned)b) << 16); }
__device__ __forceinline__ float wave_sum(float v) {
#pragma unroll
    for (int o = 1; o < 64; o <<= 1) v += __shfl_xor(v, o);
    return v;
}
__device__ __forceinline__ float fast_exp(float x) { return __builtin_amdgcn_exp2f(x * 1.4426950408889634f); }
__device__ __forceinline__ float silu_f(float g) { return g * __builtin_amdgcn_rcpf(1.0f + fast_exp(-g)); }
__device__ __forceinline__ int tok_pos(int row) { return row < TP ? (row & (SEQ - 1)) : PAST + ((row - TP) & (DSEQ - 1)); }
__device__ __forceinline__ int tok_keyrow(int row) { if (row < TP) return row; const int s = row - TP; return TP + (s >> 6) * KSEQS + PAST + (s & 63); }

__device__ __forceinline__ float rstd_of(float ssq) { return 1.0f / sqrtf(ssq * (1.f / D) + EPS); }
using pg8::Unit; using pg8::BM; using pg8::HALF;
struct EpiSwiglu {
    static constexpr bool PERM = true, AFTER_DRAIN = false;
    bf16* O; const float* ssq;
    __device__ __forceinline__ void preload(float (&er)[8], const Unit& u, int wr, int fr) const {
        const int row0 = u.pm * BM + wr * 64 + fr;
#pragma unroll
        for (int ai = 0; ai < 2; ++ai)
#pragma unroll
            for (int m = 0; m < 4; ++m) er[ai * 4 + m] = ((const GAS float*)ssq)[row0 + ai * HALF + m * 16];
    }
    __device__ __forceinline__ void operator()(const f32x4 (&acc)[2][2][4][2], const Unit& u, int wr, int wc, int fr, int fq, const float (&er)[8]) const {
        const int row0 = u.pm * BM + wr * 64 + fr, col0 = u.pn * 128 + wc * 32 + 8 * fq;
#pragma unroll
        for (int ai = 0; ai < 2; ++ai)
#pragma unroll
            for (int m = 0; m < 4; ++m) {
                const int row = row0 + ai * HALF + m * 16; const float r = rstd_of(er[ai * 4 + m]);
                bf16* rowp = O + (size_t)row * FF + col0;
                const f32x4 g0 = acc[ai][0][m][0] * r, g1 = acc[ai][0][m][1] * r, u0 = acc[ai][1][m][0] * r, u1 = acc[ai][1][m][1] * r;
                u32x4 w;
                w.x = pk2(silu_f(g0[0]) * u0[0], silu_f(g0[1]) * u0[1]); w.y = pk2(silu_f(g0[2]) * u0[2], silu_f(g0[3]) * u0[3]);
                w.z = pk2(silu_f(g1[0]) * u1[0], silu_f(g1[1]) * u1[1]); w.w = pk2(silu_f(g1[2]) * u1[2], silu_f(g1[3]) * u1[3]);
                *(u32x4*)rowp = w;
            }
    }
};
template <bool WXB, bool FIRST = false> struct EpiResid {
    static constexpr bool PERM = false, AFTER_DRAIN = false;
    float* X; float scale; float* P; bf16* XB; float* SSQ; const float* Xp; const float* Xs;
    __device__ __forceinline__ void preload(float (&)[8], const Unit&, int, int) const {}
    __device__ __forceinline__ void operator()(const f32x4 (&acc)[2][2][4][2], const Unit& u, int wr, int wc, int fr, int fq, const float (&er)[8]) const {
        const int row0 = u.pm * BM + wr * 64 + fr, col0 = u.pn * BM + wc * 32 + 4 * fq;
        if (u.part >= 0) {
#pragma unroll
            for (int ai = 0; ai < 2; ++ai)
#pragma unroll
                for (int m = 0; m < 4; ++m) {
                    float* rowp = P + ((size_t)u.part * TS + (size_t)(row0 + ai * HALF + m * 16 - TP)) * D + col0;
#pragma unroll
                    for (int bj = 0; bj < 2; ++bj)
#pragma unroll
                        for (int n = 0; n < 2; ++n) *(f32x4*)(rowp + bj * HALF + n * 16) = acc[ai][bj][m][n];
                }
            return;
        }
#pragma unroll
        for (int ai = 0; ai < 2; ++ai)
#pragma unroll
            for (int m = 0; m < 4; ++m) {
                const int row = row0 + ai * HALF + m * 16;
                float* rowp = X + (size_t)row * D + col0; float s = 0.f;
                const float* inp = FIRST ? ((row < TP ? Xp + (size_t)row * D : Xs + (size_t)(row - TP) * D) + col0) : rowp;
#pragma unroll
                for (int bj = 0; bj < 2; ++bj)
#pragma unroll
                    for (int n = 0; n < 2; ++n) { f32x4 v = *(const f32x4*)(inp + bj * HALF + n * 16); v += acc[ai][bj][m][n] * scale; *(f32x4*)(rowp + bj * HALF + n * 16) = v;
                        if constexpr (WXB) { s += (v.x * v.x + v.y * v.y) + (v.z * v.z + v.w * v.w); *(u32x2*)(XB + (size_t)row * D + col0 + bj * HALF + n * 16) = (u32x2){pk2(v.x, v.y), pk2(v.z, v.w)}; } }
                if constexpr (WXB) { s += __shfl_xor(s, 16); s += __shfl_xor(s, 32); if (fq == 0) atomicAdd(SSQ + row, s); }
            }
    }
};
struct EpiF32 {
    static constexpr bool PERM = false, AFTER_DRAIN = false;
    float* O; int ldc; const float* ssq;
    __device__ __forceinline__ void preload(float (&er)[8], const Unit& u, int wr, int fr) const {
        const int row0 = u.pm * BM + wr * 64 + fr;
#pragma unroll
        for (int ai = 0; ai < 2; ++ai)
#pragma unroll
            for (int m = 0; m < 4; ++m) er[ai * 4 + m] = ((const GAS float*)ssq)[row0 + ai * HALF + m * 16];
    }
    __device__ __forceinline__ void operator()(const f32x4 (&acc)[2][2][4][2], const Unit& u, int wr, int wc, int fr, int fq, const float (&er)[8]) const {
        const int row0 = u.pm * BM + wr * 64 + fr, col0 = u.pn * BM + wc * 32 + 4 * fq;
#pragma unroll
        for (int ai = 0; ai < 2; ++ai)
#pragma unroll
            for (int m = 0; m < 4; ++m) {
                const int row = row0 + ai * HALF + m * 16; const float r = rstd_of(er[ai * 4 + m]);
                float* rowp = O + (size_t)row * ldc + col0;
#pragma unroll
                for (int bj = 0; bj < 2; ++bj)
#pragma unroll
                    for (int n = 0; n < 2; ++n) *(f32x4*)(rowp + bj * HALF + n * 16) = acc[ai][bj][m][n] * r;
            }
    }
};
__device__ __forceinline__ float logsig16(float x) {
    const float ax = __builtin_fabsf(x);
    const float l = __builtin_amdgcn_logf(1.0f + fast_exp(-ax)) * 0.6931471805599453f;
    return (fminf(x, 0.f) - l) * 0.0625f;
}
struct EpiGlaIn {
    static constexpr bool PERM = true, AFTER_DRAIN = false;
    bf16* P; _Float16* LA; const float* bgk; const float* ssq;
    __device__ __forceinline__ void preload(float (&er)[8], const Unit& u, int wr, int fr) const {
        const int row0 = u.pm * BM + wr * 64 + fr;
#pragma unroll
        for (int ai = 0; ai < 2; ++ai)
#pragma unroll
            for (int m = 0; m < 4; ++m) er[ai * 4 + m] = ((const GAS float*)ssq)[row0 + ai * HALF + m * 16];
    }
    __device__ __forceinline__ void operator()(const f32x4 (&acc)[2][2][4][2], const Unit& u, int wr, int wc, int fr, int fq, const float (&er)[8]) const {
        const int row0 = u.pm * BM + wr * 64 + fr;
        if (u.pn < 12) {
            const int col0 = u.pn * BM + wc * 32 + 8 * fq;
#pragma unroll
            for (int ai = 0; ai < 2; ++ai)
#pragma unroll
                for (int m = 0; m < 4; ++m) {
                    const int row = row0 + ai * HALF + m * 16; const float r = rstd_of(er[ai * 4 + m]);
                    bf16* rowp = P + (size_t)row * GLA_NPROJ + col0;
#pragma unroll
                    for (int bj = 0; bj < 2; ++bj) { const f32x4 v0 = acc[ai][bj][m][0] * r, v1 = acc[ai][bj][m][1] * r; u32x4 w;
                        w.x = pk2(v0[0], v0[1]); w.y = pk2(v0[2], v0[3]); w.z = pk2(v1[0], v1[1]); w.w = pk2(v1[2], v1[3]); *(u32x4*)(rowp + bj * HALF) = w; }
                }
        } else {
            const int col0 = (u.pn - 12) * BM + wc * 32 + 8 * fq;
            f32x4 bv[2][2];
#pragma unroll
            for (int bj = 0; bj < 2; ++bj)
#pragma unroll
                for (int n = 0; n < 2; ++n) bv[bj][n] = *(const f32x4*)(bgk + col0 + bj * HALF + 4 * n);
#pragma unroll
            for (int ai = 0; ai < 2; ++ai)
#pragma unroll
                for (int m = 0; m < 4; ++m) {
                    const int row = row0 + ai * HALF + m * 16; const float r = rstd_of(er[ai * 4 + m]);
                    _Float16* rowp = LA + (size_t)row * 512 + col0;
#pragma unroll
                    for (int bj = 0; bj < 2; ++bj) {
                        const f32x4 v0 = acc[ai][bj][m][0] * r + bv[bj][0], v1 = acc[ai][bj][m][1] * r + bv[bj][1];
                        typedef _Float16 h8 __attribute__((ext_vector_type(8)));
                        h8 w; w[0] = (_Float16)logsig16(v0[0]); w[1] = (_Float16)logsig16(v0[1]); w[2] = (_Float16)logsig16(v0[2]); w[3] = (_Float16)logsig16(v0[3]);
                        w[4] = (_Float16)logsig16(v1[0]); w[5] = (_Float16)logsig16(v1[1]); w[6] = (_Float16)logsig16(v1[2]); w[7] = (_Float16)logsig16(v1[3]);
                        *(h8*)(rowp + bj * HALF) = w; }
                }
        }
    }
};
template <bool ROPE> struct EpiQ {
    static constexpr bool PERM = true, AFTER_DRAIN = false;
    bf16* Q; const f32x2* rope;
    __device__ __forceinline__ void preload(float (&)[8], const Unit&, int, int) const {}
    __device__ __forceinline__ void operator()(const f32x4 (&acc)[2][2][4][2], const Unit& u, int wr, int wc, int fr, int fq, const float (&er)[8]) const {
        const int row0 = u.pm * BM + wr * 64 + fr;
        if constexpr (!ROPE) {
#pragma unroll
            for (int ai = 0; ai < 2; ++ai)
#pragma unroll
                for (int m = 0; m < 4; ++m) {
                    bf16* rowp = Q + (size_t)(row0 + ai * HALF + m * 16) * 1536 + wc * 32 + 8 * fq;
#pragma unroll
                    for (int bj = 0; bj < 2; ++bj) { const f32x4 v0 = acc[ai][bj][m][0] * QSCALE, v1 = acc[ai][bj][m][1] * QSCALE; u32x4 w;
                        w.x = pk2(v0[0], v0[1]); w.y = pk2(v0[2], v0[3]); w.z = pk2(v1[0], v1[1]); w.w = pk2(v1[2], v1[3]); *(u32x4*)(rowp + (2 * u.pn + bj) * 192) = w; }
                }
        } else {
            const int head = u.pn * 4 + wc, i0 = 8 * fq;
#pragma unroll
            for (int ai = 0; ai < 2; ++ai)
#pragma unroll
                for (int m = 0; m < 4; ++m) {
                    const int row = row0 + ai * HALF + m * 16; const int pos = tok_pos(row);
                    const f32x2* rp = rope + (size_t)pos * 32 + i0;
                    bf16* qp = Q + (size_t)row * 1536 + head * 192 + 128 + i0;
#pragma unroll
                    for (int n = 0; n < 2; ++n) {
                        float o1[4], o2[4];
#pragma unroll
                        for (int e = 0; e < 4; ++e) { const f32x2 cs = rp[4 * n + e]; const float x1 = acc[ai][0][m][n][e], x2 = acc[ai][1][m][n][e];
                            o1[e] = (x1 * cs.x - x2 * cs.y) * QSCALE; o2[e] = (x1 * cs.y + x2 * cs.x) * QSCALE; }
                        *(u32x2*)(qp + 4 * n) = (u32x2){pk2(o1[0], o1[1]), pk2(o1[2], o1[3])};
                        *(u32x2*)(qp + 32 + 4 * n) = (u32x2){pk2(o2[0], o2[1]), pk2(o2[2], o2[3])};
                    }
                    asm volatile("" ::: "memory");
                }
        }
    }
};
struct EpiKV {
    static constexpr bool PERM = true, AFTER_DRAIN = false;
    bf16* KU; bf16* VU;
    __device__ __forceinline__ void preload(float (&)[8], const Unit&, int, int) const {}
    __device__ __forceinline__ void operator()(const f32x4 (&acc)[2][2][4][2], const Unit& u, int wr, int wc, int fr, int fq, const float (&er)[8]) const {
        const int row0 = u.pm * BM + wr * 64 + fr;
        bf16* base = (u.pn < 2) ? KU : VU; const int col0 = (u.pn & 1) * BM + wc * 32 + 8 * fq;
#pragma unroll
        for (int ai = 0; ai < 2; ++ai)
#pragma unroll
            for (int m = 0; m < 4; ++m) {
                bf16* rowp = base + (size_t)(row0 + ai * HALF + m * 16) * 512 + col0;
#pragma unroll
                for (int bj = 0; bj < 2; ++bj) { const f32x4 v0 = acc[ai][bj][m][0], v1 = acc[ai][bj][m][1]; u32x4 w;
                    w.x = pk2(v0[0], v0[1]); w.y = pk2(v0[2], v0[3]); w.z = pk2(v1[0], v1[1]); w.w = pk2(v1[2], v1[3]); *(u32x4*)(rowp + bj * HALF) = w; }
            }
    }
};

__device__ __forceinline__ s16x4 ds_tr(LAS const char* p) {
    typedef short v4i16_t __attribute__((ext_vector_type(4)));
    return __builtin_bit_cast(s16x4, __builtin_amdgcn_ds_read_tr16_b64_v4i16((LAS v4i16_t*)p));
}
__device__ __forceinline__ bf16x8 cat8(s16x4 a, s16x4 b) { return (bf16x8){a[0], a[1], a[2], a[3], b[0], b[1], b[2], b[3]}; }
#define MFMA32(a, b, c) __builtin_amdgcn_mfma_f32_32x32x16_bf16((a), (b), (c), 0, 0, 0)

struct Ctx {
    LAS unsigned char* lds; int tid, lane, wave, G, gw, NGW;
};
typedef const unsigned long long __attribute__((address_space(4)))* kargp_t;
__device__ __forceinline__ const float* KIN(int i) { return (const float*)((kargp_t)__builtin_amdgcn_kernarg_segment_ptr())[i]; }
__device__ __forceinline__ float* KOUT() { return (float*)((kargp_t)__builtin_amdgcn_kernarg_segment_ptr())[27]; }
__device__ __forceinline__ unsigned char* KWS() { return (unsigned char*)((kargp_t)__builtin_amdgcn_kernarg_segment_ptr())[28]; }

__device__ __forceinline__ void first_row(const Ctx& C, const float* xrow, bf16* orow, float* ssq) {
    const f32x4* xr = (const f32x4*)xrow + C.lane;
    f32x4 v[4]; float s = 0.f;
#pragma unroll
    for (int j = 0; j < 4; ++j) { v[j] = xr[64 * j]; s += (v[j].x * v[j].x + v[j].y * v[j].y) + (v[j].z * v[j].z + v[j].w * v[j].w); }
    s = wave_sum(s); if (C.lane == 0) *ssq = s;
    unsigned long long* o8 = (unsigned long long*)orow + C.lane;
#pragma unroll
    for (int j = 0; j < 4; ++j) o8[64 * j] = (unsigned long long)pk2(v[j].x, v[j].y) | ((unsigned long long)pk2(v[j].z, v[j].w) << 32);
}
__device__ __forceinline__ void add_partials(const Ctx& C, f32x4 (&v)[4], int m, const float* P, float pscale) {
#pragma unroll 2
    for (int p = 0; p < 8; ++p) { const f32x4* pr = (const f32x4*)(P + ((size_t)p * TS + (size_t)(m - TP)) * D) + C.lane;
#pragma unroll
        for (int j = 0; j < 4; ++j) v[j] += pr[64 * j] * pscale; }
}
__device__ __forceinline__ void fixup_phase(const Ctx& C, float* x, bf16* xb, float* ssq, const float* P, float pscale, const float* xs_in) {
    if (C.G != 256) return;
    for (int m = TP + C.gw; m < T; m += C.NGW) {
        f32x4* xr = (f32x4*)(x + (size_t)m * D) + C.lane; const f32x4* xi = xs_in ? (const f32x4*)(xs_in + (size_t)(m - TP) * D) + C.lane : xr;
        f32x4 v[4];
#pragma unroll
        for (int j = 0; j < 4; ++j) v[j] = xi[64 * j];
        add_partials(C, v, m, P, pscale);
        float s = 0.f;
#pragma unroll
        for (int j = 0; j < 4; ++j) { xr[64 * j] = v[j]; s += (v[j].x * v[j].x + v[j].y * v[j].y) + (v[j].z * v[j].z + v[j].w * v[j].w); }
        s = wave_sum(s); if (C.lane == 0) ssq[m] = s;
        unsigned long long* o8 = (unsigned long long*)(xb + (size_t)m * D) + C.lane;
#pragma unroll
        for (int j = 0; j < 4; ++j) o8[64 * j] = (unsigned long long)pk2(v[j].x, v[j].y) | ((unsigned long long)pk2(v[j].z, v[j].w) << 32);
    }
}
__device__ __forceinline__ void final_norm_phase(const Ctx& C, float* x, const float* g, const float* P, float pscale) {
    const bool split = (C.G == 256);
    for (int m = C.gw; m < T; m += C.NGW) {
        f32x4* xr = (f32x4*)(x + (size_t)m * D) + C.lane; const f32x4* gr = (const f32x4*)g + C.lane;
        f32x4 v[4]; float s = 0.f;
#pragma unroll
        for (int j = 0; j < 4; ++j) v[j] = xr[64 * j];
        if (split && m >= TP) add_partials(C, v, m, P, pscale);
#pragma unroll
        for (int j = 0; j < 4; ++j) s += (v[j].x * v[j].x + v[j].y * v[j].y) + (v[j].z * v[j].z + v[j].w * v[j].w);
        const float rstd = 1.0f / sqrtf(wave_sum(s) * (1.f / D) + EPS);
#pragma unroll
        for (int j = 0; j < 4; ++j) xr[64 * j] = v[j] * rstd * gr[64 * j];
    }
}

__device__ __forceinline__ void tr_item(const float* W, int ldw, int k0, bf16* WT, int Kd, int dst_row0, LAS float* scr, int lane, const float* gain) {
#pragma unroll 16
    for (int i = 0; i < 32; ++i) { const int kk = 2 * i + (lane >> 5); float v = W[(size_t)(k0 + kk) * ldw + (lane & 31)]; if (gain) v *= gain[k0 + kk]; scr[kk * 33 + (lane & 31)] = v; }
    asm volatile("s_waitcnt lgkmcnt(0)" ::: "memory");
    const int c = lane & 7;
#pragma unroll
    for (int j = 0; j < 4; ++j) { const int n = (lane >> 3) + 8 * j; const LAS float* s = scr + (8 * c) * 33 + n;
        u32x4 o; o.x = pk2(s[0 * 33], s[1 * 33]); o.y = pk2(s[2 * 33], s[3 * 33]); o.z = pk2(s[4 * 33], s[5 * 33]); o.w = pk2(s[6 * 33], s[7 * 33]);
        *(u32x4*)(WT + (size_t)(dst_row0 + n) * Kd + k0 + 8 * c) = o; }
    asm volatile("s_waitcnt lgkmcnt(0)" ::: "memory");
}
enum { MAP_ID = 0, MAP_GATE = 1, MAP_UP = 2, MAP_UQ = 3, MAP_UK = 4, MAP_UV = 5 };
__device__ __forceinline__ int map_row(int map, int n) {
    switch (map) {
        case MAP_GATE: return 256 * (n >> 7) + (n & 127);
        case MAP_UP:   return 256 * (n >> 7) + 128 + (n & 127);
        case MAP_UQ: { const int h = n / 192, d = n - h * 192;
            if (d < 128) return h * 128 + d;
            if (d < 160) return 1024 + (h >> 2) * 256 + (h & 3) * 32 + (d - 128);
            return 1024 + (h >> 2) * 256 + 128 + (h & 3) * 32 + (d - 160); }
        case MAP_UK: { const int h = n >> 7, d = n & 127; return (h >> 2) * 1024 + (h & 3) * 128 + d; }
        case MAP_UV: { const int h = n >> 7, d = n & 127; return (h >> 2) * 1024 + 512 + (h & 3) * 128 + d; }
        default: return n;
    }
}
__device__ __forceinline__ bool tr_job(int& it, const float* W, int ldw, int K, int ncols, bf16* WT, int Kd, int map, LAS float* scr, int lane, const float* gain = nullptr) {
    const int nblk = ncols >> 5, items = (K >> 6) * nblk;
    if (it >= items) { it -= items; return false; }
    const int kb = it / nblk, nb = it - kb * nblk;
    tr_item(W + nb * 32, ldw, kb * 64, WT, Kd, map_row(map, nb * 32), scr, lane, gain);
    return true;
}

__constant__ double c_invfreq[32] = {1.0, 0.7498942093324559, 0.5623413251903491, 0.4216965034285822, 0.31622776601683794, 0.23713737056616552, 0.1778279410038923, 0.1333521432163324, 0.1,
    0.07498942093324558, 0.05623413251903491, 0.042169650342858224, 0.03162277660168379, 0.023713737056616554, 0.01778279410038923, 0.01333521432163324, 0.01, 0.007498942093324558,
    0.005623413251903491, 0.004216965034285823, 0.0031622776601683794, 0.0023713737056616554, 0.0017782794100389228, 0.001333521432163324, 0.001, 0.0007498942093324559, 0.0005623413251903491,
    0.00042169650342858224, 0.00031622776601683794, 0.00023713737056616554, 0.00017782794100389227, 0.0001333521432163324};

constexpr int I_W1 = (D / 64) * (FF / 32), I_W2 = (FF / 64) * (D / 32), I_FFN = 2 * I_W1 + I_W2;
constexpr int I_GLAIN = (D / 64) * (GLA_NPROJ / 32), I_SQ = (D / 64) * (D / 32), I_DOWN = (D / 64) * (704 / 32), I_UQ = (384 / 64) * (1536 / 32), I_UKV = (256 / 64) * (1024 / 32);
constexpr int N_EARLY = I_FFN + I_GLAIN, NITEMS = 4 * I_FFN + I_GLAIN + I_SQ + I_DOWN + I_UQ + 2 * I_UKV + I_SQ;
__device__ __forceinline__ void tr_dispatch(int it, LAS float* scr, int lane) {
    unsigned char* wsW = KWS() + WS_W;
    bool done = false;
    { const float* gn = KIN(5);
      done = tr_job(it, KIN(6), FF, D, FF, (bf16*)(wsW + WO_FFN), D, MAP_GATE, scr, lane, gn);
      if (!done) done = tr_job(it, KIN(7), FF, D, FF, (bf16*)(wsW + WO_FFN), D, MAP_UP, scr, lane, gn);
      if (!done) done = tr_job(it, KIN(8), D, FF, D, (bf16*)(wsW + WO_FFN + W1T_B), FF, MAP_ID, scr, lane); }
    if (!done) done = tr_job(it, KIN(14), 3088, D, GLA_NPROJ, (bf16*)(wsW + WO_GLAIN), D, MAP_ID, scr, lane, KIN(9));
    if (!done) done = tr_job(it, KIN(18), D, D, D, (bf16*)(wsW + WO_GLAOUT), D, MAP_ID, scr, lane);
#pragma unroll 1
    for (int f = 1; f < 4 && !done; ++f) {
        const int layer = f >> 1, second = f & 1;
        const float* wg = (second ? KIN(11) : KIN(6)) + (size_t)layer * D * FF; const float* wu = (second ? KIN(12) : KIN(7)) + (size_t)layer * D * FF; const float* wd = (second ? KIN(13) : KIN(8)) + (size_t)layer * FF * D;
        bf16* w1t = (bf16*)(wsW + WO_FFN + f * FFN_B); bf16* w2t = (bf16*)(wsW + WO_FFN + f * FFN_B + W1T_B);
        const float* gn = (second ? KIN(10) : KIN(5)) + (size_t)layer * D;
        done = tr_job(it, wg, FF, D, FF, w1t, D, MAP_GATE, scr, lane, gn);
        if (!done) done = tr_job(it, wu, FF, D, FF, w1t, D, MAP_UP, scr, lane, gn);
        if (!done) done = tr_job(it, wd, D, FF, D, w2t, FF, MAP_ID, scr, lane);
    }
    if (!done) done = tr_job(it, KIN(19), 704, D, 704, (bf16*)(wsW + WO_DOWN), D, MAP_ID, scr, lane, KIN(9) + D);
    if (!done) done = tr_job(it, KIN(21), 1536, 384, 1536, (bf16*)(wsW + WO_UQ), 384, MAP_UQ, scr, lane);
    if (!done) done = tr_job(it, KIN(23), 1024, 256, 1024, (bf16*)(wsW + WO_KVUP), 256, MAP_UK, scr, lane);
    if (!done) done = tr_job(it, KIN(24), 1024, 256, 1024, (bf16*)(wsW + WO_KVUP), 256, MAP_UV, scr, lane);
    if (!done) done = tr_job(it, KIN(25), D, D, D, (bf16*)(wsW + WO_MLAOUT), D, MAP_ID, scr, lane);
}
__device__ __forceinline__ void late_weights(const Ctx& C, int hf) {
    constexpr int N_LATE = NITEMS - N_EARLY, HALF_LATE = (N_LATE + 1) / 2;
    const int lo = N_EARLY + hf * HALF_LATE, hi = (hf == 0) ? N_EARLY + HALF_LATE : NITEMS;
    LAS float* scr = (LAS float*)(C.lds + C.wave * 16384);
    const int widx = blockIdx.x * 6 + (C.wave - 2), nw = C.G * 6;
    for (int it = lo + widx; it < hi; it += nw) tr_dispatch(it, scr, C.lane);
}

__device__ __forceinline__ void prologue(const Ctx& C) {
    unsigned char* wsW = KWS() + WS_W;
    LAS float* scr = (LAS float*)(C.lds + C.wave * 16384);
    if (blockIdx.x == 0) for (int i = C.tid; i < 1024; i += NTHR) ((unsigned*)(KWS() + WS_CTL))[i] = 0u;
    for (int it0 = C.gw; it0 < N_EARLY; it0 += C.NGW) tr_dispatch(it0, scr, C.lane);
    const int gt = C.gw * 64 + C.lane, NGT = C.NGW * 64;
    { float* z = (float*)(KWS() + WS_SSQ) + T; for (int i = gt; i < 5 * T; i += NGT) z[i] = 0.f; }
    { u32x4* z = (u32x4*)(wsW + WO_DOWN + (size_t)704 * D * 2); for (int i = gt; i < 64 * D * 2 / 16; i += NGT) z[i] = (u32x4){0u, 0u, 0u, 0u}; }
    { const float* win = KIN(14); const float* wup = KIN(15); bf16* dst = (bf16*)(wsW + WO_GLAIN) + (size_t)GLA_NPROJ * D;
      for (int i = gt; i < 512 * 128; i += NGT) { const int n = i >> 7, kc = (i & 127) * 8; float up[16];
#pragma unroll
          for (int r = 0; r < 16; ++r) up[r] = wup[r * 512 + n];
          float o[8];
#pragma unroll
          for (int j = 0; j < 8; ++j) { const f32x4* lr = (const f32x4*)(win + (size_t)(kc + j) * 3088 + 3072); float s = 0.f;
#pragma unroll
              for (int q = 0; q < 4; ++q) { const f32x4 v = lr[q]; s += v.x * up[4 * q] + v.y * up[4 * q + 1] + v.z * up[4 * q + 2] + v.w * up[4 * q + 3]; }
              o[j] = s * KIN(9)[kc + j]; }
          u32x4 w; w.x = pk2(o[0], o[1]); w.y = pk2(o[2], o[3]); w.z = pk2(o[4], o[5]); w.w = pk2(o[6], o[7]);
          *(u32x4*)(dst + (size_t)n * D + kc) = w; } }
    { f32x2* tab = (f32x2*)(KWS() + WS_ROPE);
      for (int i = gt; i < SEQ * 32; i += NGT) { const int pos = i >> 5, k = i & 31;
          const double t = (double)pos * c_invfreq[k]; const double TWO_PI = 6.283185307179586476925286766559;
          const double kk = __builtin_rint(t * (1.0 / TWO_PI)); const double x = t - kk * TWO_PI; const double x2 = x * x;
          double sn = -1.0 / 51090942171709440000.0;
          sn = sn * x2 + 1.0 / 121645100408832000.0; sn = sn * x2 - 1.0 / 355687428096000.0; sn = sn * x2 + 1.0 / 1307674368000.0; sn = sn * x2 - 1.0 / 6227020800.0;
          sn = sn * x2 + 1.0 / 39916800.0; sn = sn * x2 - 1.0 / 362880.0; sn = sn * x2 + 1.0 / 5040.0; sn = sn * x2 - 1.0 / 120.0; sn = sn * x2 + 1.0 / 6.0; sn = -sn * x2 + 1.0; sn = sn * x;
          double cs = 1.0 / 2432902008176640000.0;
          cs = cs * x2 - 1.0 / 6402373705728000.0; cs = cs * x2 + 1.0 / 20922789888000.0; cs = cs * x2 - 1.0 / 87178291200.0; cs = cs * x2 + 1.0 / 479001600.0;
          cs = cs * x2 - 1.0 / 3628800.0; cs = cs * x2 + 1.0 / 40320.0; cs = cs * x2 - 1.0 / 720.0; cs = cs * x2 + 1.0 / 24.0; cs = cs * x2 - 0.5; cs = cs * x2 + 1.0;
          tab[i] = (f32x2){(float)cs, (float)sn}; } }
    for (int m = C.gw; m < T; m += C.NGW) {
        const float* src = (m < TP) ? KIN(0) + (size_t)m * D : KIN(1) + (size_t)(m - TP) * D;
        first_row(C, src, (bf16*)(KWS() + WS_HB) + (size_t)m * D, (float*)(KWS() + WS_SSQ) + m);
    }
}

__device__ __forceinline__ void mla_post_phase(const Ctx& C) {
    const float* down = (const float*)(KWS() + WS_BIG + BG_DOWN);
    bf16* cqn = (bf16*)(KWS() + WS_US + US_CQN); bf16* ckvn = (bf16*)(KWS() + WS_US + US_CKVN); bf16* kpeb = (bf16*)(KWS() + WS_US + US_KPEB);
    const float* qn = KIN(20); const float* kvn = KIN(22); const f32x2* rope = (const f32x2*)(KWS() + WS_ROPE);
    const int lane = C.lane;
    for (int m = C.gw; m < T; m += C.NGW) {
        const float* r = down + (size_t)m * 768;
        f32x2 a[3]; float s = 0.f;
#pragma unroll
        for (int j = 0; j < 3; ++j) { a[j] = *(const f32x2*)(r + 2 * lane + 128 * j); s += a[j].x * a[j].x + a[j].y * a[j].y; }
        const float rstd = 1.0f / sqrtf(wave_sum(s) * (1.f / 384.f) + EPS);
#pragma unroll
        for (int j = 0; j < 3; ++j) { const f32x2 g = *(const f32x2*)(qn + 2 * lane + 128 * j); *(unsigned*)(cqn + (size_t)m * 384 + 2 * lane + 128 * j) = pk2(a[j].x * rstd * g.x, a[j].y * rstd * g.y); }
        const f32x4 v = *(const f32x4*)(r + 384 + 4 * lane);
        const float s2 = (v.x * v.x + v.y * v.y) + (v.z * v.z + v.w * v.w);
        const float rstd2 = 1.0f / sqrtf(wave_sum(s2) * (1.f / 256.f) + EPS);
        const f32x4 o = v * rstd2 * *(const f32x4*)(kvn + 4 * lane);
        float* ockv = (m < TP) ? KOUT() + O_CKVP + (size_t)m * 256 : KOUT() + O_CKVS + (size_t)(m - TP) * 256;
        *(f32x4*)(ockv + 4 * lane) = o;
        const int kr = tok_keyrow(m);
        *(u32x2*)(ckvn + (size_t)kr * 256 + 4 * lane) = (u32x2){pk2(o.x, o.y), pk2(o.z, o.w)};
        const int pos = tok_pos(m);
        if (lane < 32) {
            const float x1 = r[640 + lane], x2 = r[672 + lane]; const f32x2 cs = rope[(size_t)pos * 32 + lane];
            const float o1 = x1 * cs.x - x2 * cs.y, o2 = x1 * cs.y + x2 * cs.x;
            float* okpe = (m < TP) ? KOUT() + O_KPEP + (size_t)m * 64 : KOUT() + O_KPES + (size_t)(m - TP) * 64;
            okpe[lane] = o1; okpe[32 + lane] = o2;
            kpeb[(size_t)kr * 64 + lane] = (bf16)f2bf(o1); kpeb[(size_t)kr * 64 + 32 + lane] = (bf16)f2bf(o2);
        }
    }
    const int gt = C.gw * 64 + C.lane, NGT = C.NGW * 64;
    const float* cckv = KIN(3); const float* ckpe = KIN(4);
    for (int i = gt; i < DB * PAST * 40; i += NGT) {
        const int row = i / 40, pc = i - row * 40; const int b = row >> 10, j = row & 1023; const size_t kr = (size_t)TP + b * KSEQS + j;
        const float* src; bf16* dst;
        if (pc < 32) { src = cckv + (size_t)row * 256 + pc * 8; dst = ckvn + kr * 256 + pc * 8; } else { src = ckpe + (size_t)row * 64 + (pc - 32) * 8; dst = kpeb + kr * 64 + (pc - 32) * 8; }
        const f32x4 v0 = *(const f32x4*)src, v1 = *(const f32x4*)(src + 4);
        *(u32x4*)dst = (u32x4){pk2(v0.x, v0.y), pk2(v0.z, v0.w), pk2(v1.x, v1.y), pk2(v1.z, v1.w)};
    }
}

struct GlaSlot { int row0, h, b, hh; bool sample; };
__device__ __forceinline__ GlaSlot gla_slot(int slot, int hf) {
    GlaSlot s;
    if (slot < 1024) { const int sh = slot >> 7, c = slot & 127; s.b = sh >> 1; s.hh = sh & 1; s.row0 = s.b * SEQ + 64 * c; s.sample = false; }
    else { const int q = slot - 1024; s.b = q >> 1; s.hh = q & 1; s.row0 = TP + s.b * DSEQ; s.sample = true; }
    s.h = 2 * hf + s.hh; return s;
}
constexpr int KT_STR = 320, VT_STR = 576, QD_STR = 272, PP_STR = 144, OF_STR = 1040;
__device__ __forceinline__ void gla_pass_a(const Ctx& C, int hf) {
    const bf16* PROJ = (const bf16*)(KWS() + WS_BIG + BG_PROJ); const _Float16* LA = (const _Float16*)(KWS() + WS_BIG + BG_LA);
    bf16* US = (bf16*)(KWS() + WS_US); float* DEC = (float*)(KWS() + WS_DEC);
    LAS unsigned char* KT = C.lds; LAS unsigned char* VT = C.lds + 20480; LAS float* SEG = (LAS float*)(C.lds + 57344);
    const int tid = C.tid, lane = C.lane, w = C.wave, col = tid & 127, seg = tid >> 7;
    const int h2 = lane >> 5, cb = (lane >> 4) & 1, qq = (lane & 15) >> 2, p4 = lane & 3, r32 = lane & 31;
    for (int slot = blockIdx.x; slot < NSLOT; slot += C.G) {
        const GlaSlot S = gla_slot(slot, hf);
        const _Float16* la = LA + (size_t)(S.row0 + 16 * seg) * 512 + S.h * 128 + col;
        const bf16* kp = PROJ + (size_t)(S.row0 + 16 * seg) * GLA_NPROJ + 512 + S.h * 128 + col;
        float cs[16], kv[16]; float run = 0.f;
#pragma unroll
        for (int i = 0; i < 16; ++i) { run += (float)la[(size_t)i * 512]; cs[i] = run; kv[i] = bf2f(kp[(size_t)i * GLA_NPROJ]); }
        SEG[seg * 128 + col] = run;
#pragma unroll
        for (int i = 0; i < 4; ++i) { const int p = tid + 512 * i, r = p >> 5, ch = p & 31;
            const u32x4 v = *(const u32x4*)(PROJ + (size_t)(S.row0 + r) * GLA_NPROJ + 1024 + S.h * 256 + ch * 8);
            *(LAS u32x4*)(VT + r * VT_STR + ch * 16) = v; }
        __syncthreads();
        float pre = 0.f, tot = 0.f;
#pragma unroll
        for (int s = 0; s < 4; ++s) { const float x = SEG[s * 128 + col]; tot += x; if (s < seg) pre += x; }
#pragma unroll
        for (int i = 0; i < 16; ++i) { const float bb = pre + cs[i]; *(LAS bf16*)(KT + (16 * seg + i) * KT_STR + col * 2) = (bf16)f2bf(kv[i] * fast_exp(tot - bb)); }
        if (seg == 0) DEC[(size_t)slot * 128 + col] = fast_exp(tot);
        __syncthreads();
        const int dkt = w & 3, dvg = w >> 2;
        f32x16 acc[4];
#pragma unroll
        for (int j = 0; j < 4; ++j) acc[j] = (f32x16){};
#pragma unroll
        for (int ks = 0; ks < 4; ++ks) {
            const int krow = 16 * ks + 8 * h2 + qq;
            LAS const unsigned char* bp = KT + krow * KT_STR + (32 * dkt + 16 * cb + 4 * p4) * 2;
            const bf16x8 bfr = cat8(ds_tr((LAS const char*)bp), ds_tr((LAS const char*)(bp + 4 * KT_STR)));
#pragma unroll
            for (int j = 0; j < 4; ++j) {
                LAS const unsigned char* ap = VT + krow * VT_STR + (32 * (dvg * 4 + j) + 16 * cb + 4 * p4) * 2;
                const bf16x8 afr = cat8(ds_tr((LAS const char*)ap), ds_tr((LAS const char*)(ap + 4 * VT_STR)));
                acc[j] = MFMA32(afr, bfr, acc[j]);
            }
        }
        bf16* us = US + (size_t)slot * 32768 + (size_t)(32 * dkt + r32) * 256;
#pragma unroll
        for (int j = 0; j < 4; ++j)
#pragma unroll
            for (int g = 0; g < 4; ++g) {
                const int dv = 32 * (dvg * 4 + j) + 8 * g + 4 * h2;
                *(u32x2*)(us + dv) = (u32x2){pk2(acc[j][4 * g], acc[j][4 * g + 1]), pk2(acc[j][4 * g + 2], acc[j][4 * g + 3])};
            }
        __syncthreads();
    }
}
__device__ __forceinline__ void gla_pass_b(const Ctx& C, int hf) {
    bf16* US = (bf16*)(KWS() + WS_US); const float* DEC = (const float*)(KWS() + WS_DEC);
    const int gwv = C.wave * C.G + blockIdx.x;
    const int nwv = NWAVES * C.G;
    const int npw = 512;
    if (gwv < npw) {
        const int gid = gwv * 64 + C.lane; const int sh = gid >> 12, e = gid & 4095, dk = e >> 5;
        const int b = sh >> 1, h = 2 * hf + (sh & 1);
        float S[8];
#pragma unroll
        for (int j = 0; j < 8; ++j) S[j] = 0.f;
        u32x4* up = (u32x4*)(US + (size_t)(sh * 128) * 32768) + e;
        const float* dp = DEC + (size_t)(sh * 128) * 128 + dk;
        u32x4 ua[8], ub[8]; float da[8], db[8];
#define PB_LOAD(U, Dd, c0) do { _Pragma("unroll") for (int k = 0; k < 8; ++k) { U[k] = up[(size_t)((c0) + k) * 4096]; Dd[k] = dp[((c0) + k) * 128]; } } while (0)
#define PB_STEP(U, Dd, c0) do { _Pragma("unroll") for (int k = 0; k < 8; ++k) { const u32x4 u = U[k]; const float d = Dd[k]; \
            u32x4 o; o.x = pk2(S[0], S[1]); o.y = pk2(S[2], S[3]); o.z = pk2(S[4], S[5]); o.w = pk2(S[6], S[7]); up[(size_t)((c0) + k) * 4096] = o; \
            S[0] = d * S[0] + __uint_as_float(u.x << 16); S[1] = d * S[1] + __uint_as_float(u.x & 0xffff0000u); \
            S[2] = d * S[2] + __uint_as_float(u.y << 16); S[3] = d * S[3] + __uint_as_float(u.y & 0xffff0000u); \
            S[4] = d * S[4] + __uint_as_float(u.z << 16); S[5] = d * S[5] + __uint_as_float(u.z & 0xffff0000u); \
            S[6] = d * S[6] + __uint_as_float(u.w << 16); S[7] = d * S[7] + __uint_as_float(u.w & 0xffff0000u); } } while (0)
        PB_LOAD(ua, da, 0);
#pragma unroll 1
        for (int c0 = 0; c0 < 128; c0 += 16) {
            PB_LOAD(ub, db, c0 + 8);
            PB_STEP(ua, da, c0);
            if (c0 + 16 < 128) PB_LOAD(ua, da, c0 + 16);
            PB_STEP(ub, db, c0 + 8);
        }
#undef PB_LOAD
#undef PB_STEP
        float* o = KOUT() + O_GLAP + ((size_t)(b * 4 + h) * 32768) + (size_t)e * 8;
        *(f32x4*)o = (f32x4){S[0], S[1], S[2], S[3]}; *(f32x4*)(o + 4) = (f32x4){S[4], S[5], S[6], S[7]};
    } else {
        const int nsw = nwv - npw;
        for (int q = gwv - npw; q < 64 * 64; q += nsw) {
            const int gid = q * 64 + C.lane; const int ss = gid >> 12, e = gid & 4095, dk = e >> 5;
            const int b = ss >> 1, h = 2 * hf + (ss & 1); const int slot = 1024 + ss;
            const float* s0 = KIN(2) + ((size_t)(b * 4 + h) * 32768) + (size_t)e * 8;
            const f32x4 a0 = *(const f32x4*)s0, a1 = *(const f32x4*)(s0 + 4);
            u32x4* up = (u32x4*)(US + (size_t)slot * 32768) + e; const u32x4 u = *up; const float d = DEC[(size_t)slot * 128 + dk];
            *up = (u32x4){pk2(a0.x, a0.y), pk2(a0.z, a0.w), pk2(a1.x, a1.y), pk2(a1.z, a1.w)};
            float* o = KOUT() + O_GLAS + ((size_t)(b * 4 + h) * 32768) + (size_t)e * 8;
            *(f32x4*)o = (f32x4){d * a0.x + __uint_as_float(u.x << 16), d * a0.y + __uint_as_float(u.x & 0xffff0000u), d * a0.z + __uint_as_float(u.y << 16), d * a0.w + __uint_as_float(u.y & 0xffff0000u)};
            *(f32x4*)(o + 4) = (f32x4){d * a1.x + __uint_as_float(u.z << 16), d * a1.y + __uint_as_float(u.z & 0xffff0000u), d * a1.z + __uint_as_float(u.w << 16), d * a1.w + __uint_as_float(u.w & 0xffff0000u)};
        }
    }
    if (C.wave >= 2) late_weights(C, hf);
}
__device__ __forceinline__ void gla_pass_c(const Ctx& C, int hf) {
    const bf16* PROJ = (const bf16*)(KWS() + WS_BIG + BG_PROJ); const _Float16* LA = (const _Float16*)(KWS() + WS_BIG + BG_LA);
    const bf16* US = (const bf16*)(KWS() + WS_US); bf16* HB = (bf16*)(KWS() + WS_HB); const float* gnorm = KIN(17);
    LAS unsigned char* QD = C.lds; LAS unsigned char* KI = C.lds + 17408; LAS unsigned char* VT = C.lds + 34816; LAS unsigned char* PP = C.lds + 71680;
    LAS float* SEG = (LAS float*)(C.lds + 80896); LAS unsigned char* SS = C.lds + 82944; LAS unsigned char* OF = SS;
    const int tid = C.tid, lane = C.lane, w = C.wave, col = tid & 127, seg = tid >> 7;
    const int h2 = lane >> 5, cb = (lane >> 4) & 1, qq = (lane & 15) >> 2, p4 = lane & 3, r32 = lane & 31;
    for (int slot = blockIdx.x; slot < NSLOT; slot += C.G) {
        const GlaSlot S = gla_slot(slot, hf);
        const _Float16* la = LA + (size_t)(S.row0 + 16 * seg) * 512 + S.h * 128 + col;
        const bf16* qp = PROJ + (size_t)(S.row0 + 16 * seg) * GLA_NPROJ + S.h * 128 + col;
        float cs[16], kv[16], qv[16]; float run = 0.f;
#pragma unroll
        for (int i = 0; i < 16; ++i) { run += (float)la[(size_t)i * 512]; cs[i] = run; qv[i] = bf2f(qp[(size_t)i * GLA_NPROJ]); kv[i] = bf2f(qp[(size_t)i * GLA_NPROJ + 512]); }
        SEG[seg * 128 + col] = run;
#pragma unroll
        for (int i = 0; i < 4; ++i) { const int p = tid + 512 * i, r = p >> 5, ch = p & 31;
            const u32x4 v = *(const u32x4*)(PROJ + (size_t)(S.row0 + r) * GLA_NPROJ + 1024 + S.h * 256 + ch * 8);
            *(LAS u32x4*)(VT + r * VT_STR + ch * 16) = v; }
#pragma unroll
        for (int i = 0; i < 8; ++i) { const int p = tid + 512 * i, r = p >> 5, ch = p & 31;
            const u32x4 v = *(const u32x4*)(US + (size_t)slot * 32768 + r * 256 + ch * 8);
            *(LAS u32x4*)(SS + r * VT_STR + ch * 16) = v; }
        __syncthreads();
        float pre = 0.f;
#pragma unroll
        for (int s = 0; s < 4; ++s) { const float x = SEG[s * 128 + col]; if (s < seg) pre += x; }
#pragma unroll
        for (int i = 0; i < 16; ++i) { const float bb = pre + cs[i]; const int t = 16 * seg + i;
            *(LAS bf16*)(QD + t * QD_STR + col * 2) = (bf16)f2bf(qv[i] * 0.08838834764831845f * fast_exp(bb));
            *(LAS bf16*)(KI + t * QD_STR + col * 2) = (bf16)f2bf(kv[i] * fast_exp(-bb)); }
        __syncthreads();
        if (w < 4) {
            const int st = w >> 1, tt = (w == 0) ? 0 : (w == 3 ? 0 : 1);
            f32x16 sc = (f32x16){};
            if (w < 3) {
#pragma unroll
                for (int ks = 0; ks < 8; ++ks) {
                    const bf16x8 a = *(LAS const bf16x8*)(KI + (32 * st + r32) * QD_STR + (16 * ks + 8 * h2) * 2);
                    const bf16x8 b = *(LAS const bf16x8*)(QD + (32 * tt + r32) * QD_STR + (16 * ks + 8 * h2) * 2);
                    sc = MFMA32(a, b, sc);
                }
            }
            const int t = 32 * tt + r32;
#pragma unroll
            for (int g = 0; g < 4; ++g) { const int s0 = 32 * st + 8 * g + 4 * h2; float v[4];
#pragma unroll
                for (int e = 0; e < 4; ++e) v[e] = (s0 + e <= t) ? sc[4 * g + e] : 0.f;
                *(LAS u32x2*)(PP + t * PP_STR + s0 * 2) = (u32x2){pk2(v[0], v[1]), pk2(v[2], v[3])}; }
        }
        __syncthreads();
        f32x16 oc[2]; oc[0] = (f32x16){}; oc[1] = (f32x16){};
#pragma unroll
        for (int ks = 0; ks < 4; ++ks) {
            LAS const unsigned char* bp = VT + (16 * ks + 8 * h2 + qq) * VT_STR + (32 * w + 16 * cb + 4 * p4) * 2;
            const bf16x8 bfr = cat8(ds_tr((LAS const char*)bp), ds_tr((LAS const char*)(bp + 4 * VT_STR)));
#pragma unroll
            for (int tt = 0; tt < 2; ++tt) { const bf16x8 a = *(LAS const bf16x8*)(PP + (32 * tt + r32) * PP_STR + (16 * ks + 8 * h2) * 2); oc[tt] = MFMA32(a, bfr, oc[tt]); }
        }
#pragma unroll
        for (int ks = 0; ks < 8; ++ks) {
            LAS const unsigned char* bp = SS + (16 * ks + 8 * h2 + qq) * VT_STR + (32 * w + 16 * cb + 4 * p4) * 2;
            const bf16x8 bfr = cat8(ds_tr((LAS const char*)bp), ds_tr((LAS const char*)(bp + 4 * VT_STR)));
#pragma unroll
            for (int tt = 0; tt < 2; ++tt) { const bf16x8 a = *(LAS const bf16x8*)(QD + (32 * tt + r32) * QD_STR + (16 * ks + 8 * h2) * 2); oc[tt] = MFMA32(a, bfr, oc[tt]); }
        }
        __syncthreads();
#pragma unroll
        for (int tt = 0; tt < 2; ++tt)
#pragma unroll
            for (int r = 0; r < 16; ++r) { const int t = 32 * tt + (r & 3) + 8 * (r >> 2) + 4 * h2; *(LAS float*)(OF + t * OF_STR + (32 * w + r32) * 4) = oc[tt][r]; }
        __syncthreads();
        {
            const int t = tid >> 3, part = tid & 7; const int row = S.row0 + t;
            f32x4 v[8]; float ssq = 0.f;
#pragma unroll
            for (int j = 0; j < 8; ++j) { v[j] = *(LAS const f32x4*)(OF + t * OF_STR + (j * 32 + part * 4) * 4); ssq += (v[j].x * v[j].x + v[j].y * v[j].y) + (v[j].z * v[j].z + v[j].w * v[j].w); }
            ssq += __shfl_xor(ssq, 1); ssq += __shfl_xor(ssq, 2); ssq += __shfl_xor(ssq, 4);
            const float rstd = 1.0f / sqrtf(ssq * (1.f / 256.f) + EPS);
            const bf16* gp = PROJ + (size_t)row * GLA_NPROJ + 2048 + S.h * 256; bf16* op = HB + (size_t)row * D + S.h * 256;
#pragma unroll
            for (int j = 0; j < 8; ++j) { const int dv = j * 32 + part * 4; const u32x2 gg = *(const u32x2*)(gp + dv); const f32x4 gn = *(const f32x4*)(gnorm + dv);
                const float g0 = __uint_as_float(gg.x << 16), g1 = __uint_as_float(gg.x & 0xffff0000u), g2 = __uint_as_float(gg.y << 16), g3 = __uint_as_float(gg.y & 0xffff0000u);
                *(u32x2*)(op + dv) = (u32x2){pk2(v[j].x * rstd * gn.x * silu_f(g0), v[j].y * rstd * gn.y * silu_f(g1)), pk2(v[j].z * rstd * gn.z * silu_f(g2), v[j].w * rstd * gn.w * silu_f(g3))}; }
        }
        __syncthreads();
    }
}

constexpr int AK_STR = 400, AV_STR = 320, AKB = 64 * AK_STR, AVB = 64 * AV_STR;
__device__ __forceinline__ void attn_phase(const Ctx& C, int hf) {
    const bf16* Q = (const bf16*)(KWS() + WS_BIG + BG_Q); const bf16* KU = (const bf16*)(KWS() + WS_BIG + BG_KU); const bf16* VU = (const bf16*)(KWS() + WS_BIG + BG_VU);
    const bf16* KPEB = (const bf16*)(KWS() + WS_US + US_KPEB); bf16* O = (bf16*)(KWS() + WS_HB);
    unsigned* ctr = (unsigned*)(KWS() + WS_CTL) + 512 + 256 * hf;
    const int xcd = (int)((unsigned)__builtin_amdgcn_s_getreg((3 << 11) | 20) & 7u);
    LAS unsigned char* KB = C.lds; LAS unsigned char* VB = C.lds + 2 * AKB; LAS int* ITEM = (LAS int*)(C.lds + 2 * AKB + 2 * AVB);
    const int tid = C.tid, lane = C.lane, w = C.wave;
    const int h2 = lane >> 5, cb = (lane >> 4) & 1, qq = (lane & 15) >> 2, p4 = lane & 3, r32 = lane & 31;
    for (;;) {
        if (tid == 0) {
            int got = -1;
            for (int k = 0; k < 8; ++k) { const int q = (xcd + k) & 7; const unsigned idx = atomicAdd(ctr + 16 * q, 1u); if (idx < 80u) { got = q * 80 + (int)idx; break; } }
            ITEM[0] = got;
        }
        __syncthreads();
        const int item = ITEM[0];
        if (item < 0) break;
        int b, hl, keyrow0, qrow0, ntb, ntw;
        { const int q = item / 80, i = item - q * 80;
          if (i < 64) { const int qb = 31 - (i >> 1), combo = 2 * q + (i & 1); b = combo >> 2; hl = combo & 3; keyrow0 = b * SEQ; qrow0 = b * SEQ + 256 * qb; ntb = 4 * qb + 4; ntw = 4 * qb + (w >> 1) + 1; }
          else { const int j = q * 16 + (i - 64); b = j >> 2; hl = j & 3; keyrow0 = TP + b * KSEQS; qrow0 = TP + b * DSEQ; ntb = 17; ntw = (w < 2) ? 17 : 0; } }
        const int head = 4 * hf + hl;
        bf16x8 qf[12];
        if (ntw > 0) {
            const GAS bf16* qp = (const GAS bf16*)(Q + (size_t)(qrow0 + 32 * w + r32) * 1536 + head * 192 + 8 * h2);
#pragma unroll
            for (int ks = 0; ks < 12; ++ks) qf[ks] = *(const GAS bf16x8*)(qp + 16 * ks);
        } else {
#pragma unroll
            for (int ks = 0; ks < 12; ++ks) qf[ks] = (bf16x8){};
        }
        f32x16 o[4];
#pragma unroll
        for (int j = 0; j < 4; ++j) o[j] = (f32x16){};
        float mrun = 0.f, lrun = 0.f;
        const int kr_ = tid >> 4, kc_ = tid & 15, pr_ = tid >> 3, pc_ = tid & 7;
        const GAS bf16* ksrc = (const GAS bf16*)(KU + (size_t)(keyrow0 + kr_) * 512 + hl * 128 + kc_ * 8);
        const GAS bf16* vsrc = (const GAS bf16*)(VU + (size_t)(keyrow0 + kr_) * 512 + hl * 128 + kc_ * 8);
        const GAS bf16* psrc = (const GAS bf16*)(KPEB + (size_t)(keyrow0 + pr_) * 64 + pc_ * 8);
        u32x4 pre[5];
#define ATT_LOAD(t) do { const size_t o_ = (size_t)(t) * 64; pre[0] = *(const GAS u32x4*)(ksrc + o_ * 512); pre[1] = *(const GAS u32x4*)(ksrc + (o_ + 32) * 512); \
        pre[2] = *(const GAS u32x4*)(vsrc + o_ * 512); pre[3] = *(const GAS u32x4*)(vsrc + (o_ + 32) * 512); pre[4] = *(const GAS u32x4*)(psrc + o_ * 64); } while (0)
#define ATT_STORE(bufi) do { LAS unsigned char* kb_ = KB + (bufi) * AKB; LAS unsigned char* vb_ = VB + (bufi) * AVB; \
        *(LAS u32x4*)(kb_ + kr_ * AK_STR + kc_ * 16) = pre[0]; *(LAS u32x4*)(kb_ + (kr_ + 32) * AK_STR + kc_ * 16) = pre[1]; \
        *(LAS u32x4*)(vb_ + kr_ * AV_STR + kc_ * 16) = pre[2]; *(LAS u32x4*)(vb_ + (kr_ + 32) * AV_STR + kc_ * 16) = pre[3]; \
        *(LAS u32x4*)(kb_ + pr_ * AK_STR + 256 + pc_ * 16) = pre[4]; } while (0)
        ATT_LOAD(0); ATT_STORE(0);
        if (ntb > 1) ATT_LOAD(1);
        __syncthreads();
        if (ntw > 0) {
            LAS const unsigned char* kb = KB + r32 * AK_STR + 16 * h2;
            f32x16 sr = (f32x16){};
#pragma unroll
            for (int ks = 0; ks < 12; ++ks) { const bf16x8 a0 = *(LAS const bf16x8*)(kb + ks * 32); sr = MFMA32(a0, qf[ks], sr); }
            float m0 = sr[0];
#pragma unroll
            for (int r = 1; r < 16; ++r) m0 = fmaxf(m0, sr[r]);
            auto rr = __builtin_amdgcn_permlane32_swap(__float_as_uint(m0), __float_as_uint(m0), false, false);
            mrun = fmaxf(__uint_as_float(rr[0]), __uint_as_float(rr[1]));
        }
        for (int t = 0; t < ntb; ++t) {
            const int cur = t & 1;
            LAS const unsigned char* kb = KB + cur * AKB + r32 * AK_STR + 16 * h2; LAS const unsigned char* vb = VB + cur * AVB;
            f32x16 s0, s1; float mx0 = 0.f, mx1 = 0.f, ls = 0.f; bf16x8 pf[4]; bf16x8 kq[3], vq[2];
            if (t < ntw) {
#pragma unroll
                for (int r = 0; r < 16; ++r) { s0[r] = -mrun; s1[r] = -mrun; }
#define ATT_KF(i) (*(LAS const bf16x8*)(kb + ((i) < 12 ? (i) * 32 : 32 * AK_STR + ((i) - 12) * 32)))
#define ATT_VF(i) cat8(ds_tr((LAS const char*)(vb + (16 * ((i) >> 2) + 4 * h2 + qq) * AV_STR + (32 * ((i) & 3) + 16 * cb + 4 * p4) * 2)), ds_tr((LAS const char*)(vb + (16 * ((i) >> 2) + 4 * h2 + qq + 8) * AV_STR + (32 * ((i) & 3) + 16 * cb + 4 * p4) * 2)))
                kq[0] = ATT_KF(0); kq[1] = ATT_KF(1); kq[2] = ATT_KF(2);
                __builtin_amdgcn_sched_barrier(0);
#pragma unroll
                for (int i = 0; i < 24; ++i) {
                    const bf16x8 ac = kq[i % 3];
                    if (i + 3 < 24) kq[i % 3] = ATT_KF(i + 3);
                    if (i == 22) vq[0] = ATT_VF(0);
                    if (i == 23) vq[1] = ATT_VF(1);
                    if (i < 12) s0 = MFMA32(ac, qf[i], s0); else s1 = MFMA32(ac, qf[i - 12], s1);
                    const int ks = i - 12;
                    if (ks == 0) mx0 = fmaxf(fmaxf(fmaxf(s0[0], s0[1]), fmaxf(s0[2], s0[3])), fmaxf(fmaxf(s0[4], s0[5]), fmaxf(s0[6], s0[7])));
                    if (ks == 1) mx0 = fmaxf(mx0, fmaxf(fmaxf(fmaxf(s0[8], s0[9]), fmaxf(s0[10], s0[11])), fmaxf(fmaxf(s0[12], s0[13]), fmaxf(s0[14], s0[15]))));
                    if (ks >= 2 && ks < 10) { const int r = 2 * (ks - 2); s0[r] = __builtin_amdgcn_exp2f(s0[r]); s0[r + 1] = __builtin_amdgcn_exp2f(s0[r + 1]); ls += s0[r] + s0[r + 1]; }
                    if (ks == 10) { const u32x4 x = (u32x4){pk2(s0[0], s0[1]), pk2(s0[2], s0[3]), pk2(s0[4], s0[5]), pk2(s0[6], s0[7])}; pf[0] = __builtin_bit_cast(bf16x8, x); }
                    if (ks == 11) { const u32x4 x = (u32x4){pk2(s0[8], s0[9]), pk2(s0[10], s0[11]), pk2(s0[12], s0[13]), pk2(s0[14], s0[15])}; pf[1] = __builtin_bit_cast(bf16x8, x); }
                    __builtin_amdgcn_sched_barrier(0);
                }
            }
            if (t + 1 < ntb) ATT_STORE(cur ^ 1);
            if (t + 2 < ntb) ATT_LOAD(t + 2);
            if (t < ntw) {
#pragma unroll
                for (int i = 0; i < 16; ++i) {
                    const int kk = i >> 2, j = i & 3;
                    const bf16x8 a = vq[i & 1];
                    if (i + 2 < 16) vq[i & 1] = ATT_VF(i + 2);
                    o[j] = MFMA32(a, pf[kk], o[j]);
                    if (i == 0) mx1 = fmaxf(fmaxf(fmaxf(s1[0], s1[1]), fmaxf(s1[2], s1[3])), fmaxf(fmaxf(s1[4], s1[5]), fmaxf(s1[6], s1[7])));
                    if (i == 1) mx1 = fmaxf(mx1, fmaxf(fmaxf(fmaxf(s1[8], s1[9]), fmaxf(s1[10], s1[11])), fmaxf(fmaxf(s1[12], s1[13]), fmaxf(s1[14], s1[15]))));
                    if (i >= 2 && i < 6) { const int r = 4 * (i - 2);
#pragma unroll
                        for (int e2 = 0; e2 < 4; ++e2) { s1[r + e2] = __builtin_amdgcn_exp2f(s1[r + e2]); ls += s1[r + e2]; } }
                    if (i == 6) { const u32x4 x = (u32x4){pk2(s1[0], s1[1]), pk2(s1[2], s1[3]), pk2(s1[4], s1[5]), pk2(s1[6], s1[7])}; pf[2] = __builtin_bit_cast(bf16x8, x); }
                    if (i == 7) { const u32x4 x = (u32x4){pk2(s1[8], s1[9]), pk2(s1[10], s1[11]), pk2(s1[12], s1[13]), pk2(s1[14], s1[15])}; pf[3] = __builtin_bit_cast(bf16x8, x); }
                    __builtin_amdgcn_sched_barrier(0);
                }
#undef ATT_KF
#undef ATT_VF
                lrun += ls;
                float mx = fmaxf(mx0, mx1);
                { auto rr = __builtin_amdgcn_permlane32_swap(__float_as_uint(mx), __float_as_uint(mx), false, false); mx = fmaxf(__uint_as_float(rr[0]), __uint_as_float(rr[1])); }
                if (__any(mx > 8.0f)) {
                    const float dl = fmaxf(mx, 0.f), alpha = __builtin_amdgcn_exp2f(-dl);
                    mrun += dl; lrun *= alpha;
#pragma unroll
                    for (int j = 0; j < 4; ++j) o[j] *= alpha;
                }
            }
            __syncthreads();
        }
#undef ATT_LOAD
#undef ATT_STORE
        if (ntw > 0) {
            const float l = lrun + __shfl_xor(lrun, 32); const float inv = 1.0f / l;
            GAS bf16* op = (GAS bf16*)(O + (size_t)(qrow0 + 32 * w + r32) * D + head * 128 + 4 * h2);
#pragma unroll
            for (int j = 0; j < 4; ++j)
#pragma unroll
                for (int g = 0; g < 4; ++g)
                    *(GAS u32x2*)(op + 32 * j + 8 * g) = (u32x2){pk2(o[j][4 * g] * inv, o[j][4 * g + 1] * inv), pk2(o[j][4 * g + 2] * inv, o[j][4 * g + 3] * inv)};
        }
    }
}

#define XB_TMO      128
#define XB_XCNT(j)  (256  + 64 * (j))
#define XB_XSUB(j)  (1280 + 64 * (j))
#define XB_XGEN(j)  (2304 + 64 * (j))
#define XB_TOP      3328
#define XB_TOPGEN   3392
#define XCD_BAR_WORDS 3456
#define XB_SPIN_CAP (1u << 18)

__device__ __forceinline__ unsigned xb_ld(unsigned* p)              { return __hip_atomic_load(p, __ATOMIC_RELAXED, __HIP_MEMORY_SCOPE_AGENT); }
__device__ __forceinline__ unsigned xb_add(unsigned* p, unsigned v) { return __hip_atomic_fetch_add(p, v, __ATOMIC_RELAXED, __HIP_MEMORY_SCOPE_AGENT); }
__device__ __forceinline__ unsigned xb_xcc_id() { return (unsigned)__builtin_amdgcn_s_getreg((3 << 11) | 20) & 0xFu; }
#define XB_SPIN(cond, bar) do { unsigned _sp = 0; while (cond) { __builtin_amdgcn_s_sleep(1); \
    if ((++_sp & 255u) == 0u) { if (xb_ld(&(bar)[XB_TMO])) break; if (_sp > XB_SPIN_CAP) { atomicAdd(&(bar)[XB_TMO], 1u); break; } } } } while (0)

struct XcdBarrier {
    unsigned* bar; unsigned x;
    volatile LAS unsigned* st;
};

__device__ __forceinline__ XcdBarrier xcd_barrier_post(unsigned* bar, volatile LAS unsigned* st) {
    XcdBarrier b; b.bar = bar; b.x = xb_xcc_id(); b.st = st;
    if (threadIdx.x == 0) (void)xb_add(&bar[XB_XCNT(b.x)], 1u);
    return b;
}
__device__ __forceinline__ void xcd_barrier_complete(unsigned* bar, unsigned x, unsigned& nloc, unsigned& nx) {
    const unsigned G = gridDim.x * gridDim.y * gridDim.z;
    unsigned sum, cnt, mine, sp = 0u;
    for (;;) {
        sum = 0u; cnt = 0u; mine = 0u;
#pragma unroll
        for (unsigned j = 0; j < 16; ++j) { const unsigned c = xb_ld(&bar[XB_XCNT(j)]); sum += c; cnt += (c > 0u) ? 1u : 0u; mine = (j == x) ? c : mine; }
        if (sum == G) break;
        __builtin_amdgcn_s_sleep(1);
        if ((++sp & 255u) == 0u) { if (xb_ld(&bar[XB_TMO])) break; if (sp > XB_SPIN_CAP) { atomicAdd(&bar[XB_TMO], 1u); break; } }
    }
    nloc = mine > 0u ? mine : 1u; nx = cnt > 0u ? cnt : 1u;
}

__device__ __forceinline__ void xcd_barrier(const XcdBarrier& b) {
    asm volatile("s_waitcnt vmcnt(0)" ::: "memory");
    __syncthreads();
    if (threadIdx.x == 0) {
        unsigned* bar = b.bar;
        __builtin_amdgcn_s_waitcnt(0);
        unsigned nloc = b.st[0], nx = b.st[1];
        if (nloc == 0u) { xcd_barrier_complete(bar, b.x, nloc, nx); b.st[0] = nloc; b.st[1] = nx; }
        const unsigned old = xb_add(&bar[XB_XSUB(b.x)], 1u);
        const unsigned gen = old / nloc;
        if (old + 1u == (gen + 1u) * nloc) {
            __builtin_amdgcn_fence(__ATOMIC_RELEASE, "agent");
            asm volatile("s_waitcnt vmcnt(0)" ::: "memory");
            const unsigned og = xb_add(&bar[XB_TOP], 1u);
            const unsigned tg = og / nx;
            if (og + 1u == (tg + 1u) * nx) xb_add(&bar[XB_TOPGEN], 1u);
            else XB_SPIN(xb_ld(&bar[XB_TOPGEN]) == tg, bar);
            __builtin_amdgcn_fence(__ATOMIC_ACQUIRE, "agent");
            xb_add(&bar[XB_XGEN(b.x)], 1u);
            asm volatile("s_waitcnt vmcnt(0)" ::: "memory");
        } else {
            XB_SPIN(xb_ld(&bar[XB_XGEN(b.x)]) == gen, bar);
            __builtin_amdgcn_fence(__ATOMIC_ACQUIRE, "agent");
            asm volatile("s_waitcnt vmcnt(0)" ::: "memory");
        }
    }
    __syncthreads();
}

using EpiResidFirst = EpiResid<true, true>;
struct Args { const float* in[27]; float* out; unsigned char* ws; int ph_lo, ph_hi; };
constexpr int NPHASE = 30;

__global__ void __launch_bounds__(NTHR, 2) mega_fwd(Args args) {
    extern __shared__ __attribute__((aligned(16))) unsigned char lds_raw[];
    Ctx C;
    C.lds = (LAS unsigned char*)lds_raw; C.tid = threadIdx.x; C.lane = C.tid & 63; C.wave = __builtin_amdgcn_readfirstlane(C.tid >> 6);
    C.G = gridDim.x; C.gw = blockIdx.x * NWAVES + C.wave; C.NGW = C.G * NWAVES;
#define ws KWS()
#define wsW (KWS() + WS_W)
#define X (KOUT() + O_Y)
#define HB ((bf16*)(KWS() + WS_HB))
    const int lo = args.ph_lo, hi = args.ph_hi;
    int ph = 0;
#if ONE_LAUNCH
    cg::grid_group grid = cg::this_grid();
    volatile LAS unsigned* bst = (volatile LAS unsigned*)(C.lds + LDS_BYTES - 64);
    if (C.tid < 2) bst[C.tid] = 0u;
    __syncthreads();
    XcdBarrier xbar = xcd_barrier_post((unsigned*)(KWS() + WS_BAR), bst);
#define SEAM() do { xcd_barrier(xbar); } while (0)
    if (lo > (1 << 28)) grid.sync();
#else
#define SEAM() do { } while (0)
#endif
#define PHASE_BEGIN if (ph >= lo && ph < hi) {
#define PHASE_END   if (ph + 1 < hi) SEAM(); } ++ph;

    PHASE_BEGIN prologue(C); PHASE_END
#define GEMM_PHASE_S(SCHED, EPI, A_, BT_, M_, N_, K_, ...) PHASE_BEGIN { pg8::Gemm g{(const bf16*)(A_), (const bf16*)(BT_), M_, N_, K_}; pg8::SCHED S; S.init(M_, N_, K_, C.G, (int)blockIdx.x); \
        EPI E{__VA_ARGS__}; pg8::gemm_phase<EPI, pg8::SCHED, true, true>(C.lds, g, S, E); } PHASE_END
#define GEMM_PHASE(...) GEMM_PHASE_S(StaticOrder, __VA_ARGS__)
#define R1 ((bf16*)(ws + WS_HB))
#define R2 ((bf16*)(ws + WS_US))
#define SSQ(i) ((float*)(ws + WS_SSQ) + (size_t)(i) * T)
#define PART_FFN ((float*)(ws + WS_US))
#define PART_MIX ((float*)(ws + WS_BIG))
#define FIXUP_PHASE(xb_, i_, P_, ps_) PHASE_BEGIN fixup_phase(C, X, xb_, SSQ(i_), P_, ps_, nullptr); PHASE_END
#define FFN_PHASES(f, xin, si, so, EPIR) \
    GEMM_PHASE(EpiSwiglu, xin, wsW + WO_FFN + (f) * FFN_B, T, 2 * FF, D, (bf16*)(ws + WS_BIG + BG_ACT), SSQ(si)) \
    GEMM_PHASE_S(SplitOrder, EPIR, ws + WS_BIG + BG_ACT, wsW + WO_FFN + (f) * FFN_B + W1T_B, T, D, FF, X, 0.5f, PART_FFN, R1, SSQ(so), KIN(0), KIN(1))
    FFN_PHASES(0, R1, 0, 1, EpiResidFirst)
    PHASE_BEGIN fixup_phase(C, X, R1, SSQ(1), PART_FFN, 0.5f, KIN(1)); PHASE_END
    GEMM_PHASE(EpiGlaIn, R1, wsW + WO_GLAIN, T, GLA_N, D, (bf16*)(ws + WS_BIG + BG_PROJ), (_Float16*)(ws + WS_BIG + BG_LA), KIN(16), SSQ(1))
    PHASE_BEGIN gla_pass_a(C, 0); PHASE_END
    PHASE_BEGIN gla_pass_b(C, 0); PHASE_END
    PHASE_BEGIN gla_pass_c(C, 0); PHASE_END
    PHASE_BEGIN gla_pass_a(C, 1); PHASE_END
    PHASE_BEGIN gla_pass_b(C, 1); PHASE_END
    PHASE_BEGIN gla_pass_c(C, 1); PHASE_END
    GEMM_PHASE_S(SplitOrder, EpiResid<true>, R1, wsW + WO_GLAOUT, T, D, D, X, 1.0f, PART_MIX, R2, SSQ(2), nullptr, nullptr)
    FIXUP_PHASE(R2, 2, PART_MIX, 1.0f)
    FFN_PHASES(1, R2, 2, 3, EpiResid<true>)
    FIXUP_PHASE(R1, 3, PART_FFN, 0.5f)
    FFN_PHASES(2, R1, 3, 4, EpiResid<true>)
    FIXUP_PHASE(R1, 4, PART_FFN, 0.5f)
    GEMM_PHASE(EpiF32, R1, wsW + WO_DOWN, T, 768, D, (float*)(ws + WS_BIG + BG_DOWN), 768, SSQ(4))
    PHASE_BEGIN mla_post_phase(C); PHASE_END
    PHASE_BEGIN
        { pg8::Gemm g{(const bf16*)(ws + WS_US + US_CQN), (const bf16*)(wsW + WO_UQ), T, 1024, 384}; pg8::StaticOrder S; S.init(T, 1024, 384, C.G, (int)blockIdx.x);
          EpiQ<false> E{(bf16*)(ws + WS_BIG + BG_Q), (const f32x2*)(ws + WS_ROPE)}; pg8::gemm_phase<EpiQ<false>, pg8::StaticOrder, true, true>(C.lds, g, S, E); }
        { pg8::Gemm g{(const bf16*)(ws + WS_US + US_CQN), (const bf16*)(wsW + WO_UQ + (size_t)1024 * 384 * 2), T, 512, 384}; pg8::StaticOrder S; S.init(T, 512, 384, C.G, (int)((blockIdx.x + 224u) % (unsigned)C.G));
          EpiQ<true> E{(bf16*)(ws + WS_BIG + BG_Q), (const f32x2*)(ws + WS_ROPE)}; pg8::gemm_phase<EpiQ<true>, pg8::StaticOrder, true, true>(C.lds, g, S, E); }
        { pg8::Gemm g{(const bf16*)(ws + WS_US + US_CKVN), (const bf16*)(wsW + WO_KVUP), TK, 1024, 256}; pg8::StaticOrder S; S.init(TK, 1024, 256, C.G, (int)((blockIdx.x + 128u) % (unsigned)C.G));
          EpiKV E{(bf16*)(ws + WS_BIG + BG_KU), (bf16*)(ws + WS_BIG + BG_VU)}; pg8::gemm_phase<EpiKV, pg8::StaticOrder, true, true>(C.lds, g, S, E); }
    PHASE_END
    PHASE_BEGIN attn_phase(C, 0); PHASE_END
    GEMM_PHASE(EpiKV, ws + WS_US + US_CKVN, wsW + WO_KVUP + (size_t)1024 * 256 * 2, TK, 1024, 256, (bf16*)(ws + WS_BIG + BG_KU), (bf16*)(ws + WS_BIG + BG_VU))
    PHASE_BEGIN attn_phase(C, 1); PHASE_END
    GEMM_PHASE_S(SplitOrder, EpiResid<true>, R1, wsW + WO_MLAOUT, T, D, D, X, 1.0f, PART_MIX, R2, SSQ(5), nullptr, nullptr)
    FIXUP_PHASE(R2, 5, PART_MIX, 1.0f)
    FFN_PHASES(3, R2, 5, 5, EpiResid<false>)
    PHASE_BEGIN final_norm_phase(C, X, KIN(26), (const float*)PART_FFN, 0.5f); PHASE_END
#undef ws
#undef wsW
#undef X
#undef HB
}

extern "C" void kernel_launch(void* const* d_in, const int* in_sizes, int n_in, void* d_out, int out_size, void* d_ws, size_t ws_size, hipStream_t stream) {
    static int grid = 0;
    if (grid == 0) {
        if (n_in != 27 || ws_size < WS_END) { fprintf(stderr, "kernel_launch: unexpected n_in %d / ws_size %zu\n", n_in, ws_size); grid = -1; return; }
        int dev = 0, cus = 0, per_cu = 0;
        hipGetDevice(&dev); hipDeviceGetAttribute(&cus, hipDeviceAttributeMultiprocessorCount, dev);
        if (hipFuncSetAttribute((const void*)mega_fwd, hipFuncAttributeMaxDynamicSharedMemorySize, LDS_BYTES) != hipSuccess) { fprintf(stderr, "kernel_launch: hipFuncSetAttribute failed\n"); grid = -1; return; }
        if (hipOccupancyMaxActiveBlocksPerMultiprocessor(&per_cu, (const void*)mega_fwd, NTHR, LDS_BYTES) != hipSuccess || per_cu < 1) { fprintf(stderr, "kernel_launch: occupancy query gave %d\n", per_cu); per_cu = 1; }
        (void)hipGetLastError();
        grid = cus * 1;
    }
    if (grid < 0) return;
    Args a{};
    for (int i = 0; i < 27; ++i) a.in[i] = (const float*)d_in[i];
    a.out = (float*)d_out; a.ws = (unsigned char*)d_ws;
#if ONE_LAUNCH
    a.ph_lo = 0; a.ph_hi = NPHASE;
    if (hipMemsetAsync((char*)d_ws + WS_BAR, 0, XCD_BAR_WORDS * 4, stream) != hipSuccess) { fprintf(stderr, "kernel_launch: memset failed\n"); return; }
    void* kargs[] = {&a};
    hipError_t e = hipLaunchCooperativeKernel((const void*)mega_fwd, dim3(grid), dim3(NTHR), kargs, LDS_BYTES, stream);
    if (e != hipSuccess) fprintf(stderr, "cooperative launch failed: %s (grid %d)\n", hipGetErrorString(e), grid);
#else
    for (int p = 0; p < NPHASE; ++p) { a.ph_lo = p; a.ph_hi = p + 1; hipLaunchKernelGGL(mega_fwd, dim3(grid), dim3(NTHR), LDS_BYTES, stream, a); }
#endif
}
```
